# Optimizing an MI355X kernel written in HIP

```python
import math
import functools
import jax
import jax.numpy as jnp
from jax import lax
import numpy as np

D_MODEL = 1024
BATCH = 4
SEQ = 4096
DEPTH = 1
DEC_BATCH = 128
DEC_SEQ = 4
PAST_LEN = 2048
PAGE_SIZE = 128

HEAD_DIM = 64
ATT_BRANCHES = ((128, 1), (512, 4), (2048, 16))
N_BRANCH = len(ATT_BRANCHES)
HEADS_PER_BRANCH = 4
ATT_HEADS = N_BRANCH * HEADS_PER_BRANCH
D_ATT = ATT_HEADS * HEAD_DIM
SSD_HEADS = 12
SSD_HEAD_DIM = 64
D_INNER = SSD_HEADS * SSD_HEAD_DIM
SSD_GROUPS = 4
SSD_HEADS_PER_GROUP = SSD_HEADS // SSD_GROUPS
SSD_STATE = 128
CONV_WIDTH = 4
CONV_DIM = D_INNER + 2 * SSD_GROUPS * SSD_STATE
SSD_CHUNK = 128
D_MIX = D_ATT + D_INNER
D_IN_TOTAL = 3 * D_ATT + D_INNER + CONV_DIM + SSD_HEADS
D_FF = ((8 * D_MODEL + 3 * 256 - 1) // (3 * 256)) * 256
RMS_EPS = 1e-5
NEG_INF = -1e30
ATT_SCALE = HEAD_DIM ** -0.5

kernel_name = 'hybrid_dilated_attn_ssd_step'


def rmsnorm(x, g):
    xf = x.astype(jnp.float32)
    inv = lax.rsqrt(jnp.mean(xf * xf, axis=-1, keepdims=True) + RMS_EPS)
    return (xf * inv * g.astype(jnp.float32)).astype(x.dtype)


def project(x, norm_mix, w_in):
    b, t = x.shape[:2]
    u = rmsnorm(x, norm_mix) @ w_in
    q, k, v = (u[..., i * D_ATT:(i + 1) * D_ATT].reshape(b, t, N_BRANCH, HEADS_PER_BRANCH, HEAD_DIM)
               for i in range(3))
    o = 3 * D_ATT
    z = u[..., o:o + D_INNER]
    o += D_INNER
    xbc = u[..., o:o + CONV_DIM]
    o += CONV_DIM
    dt_raw = u[..., o:o + SSD_HEADS]
    return q, k, v, z, xbc, dt_raw


def dilated_branch_prompt(q, k, v, window, dil):
    b, t, h, d = q.shape
    band = window // dil
    unit = band * dil
    tp = -(-t // unit) * unit
    nblk = tp // unit

    def to_blocks(a):
        a = jnp.pad(a.astype(jnp.float32), ((0, 0), (0, tp - t), (0, 0), (0, 0)))
        a = a.reshape(b, tp // dil, dil, h, d).transpose(0, 2, 1, 3, 4)
        return a.reshape(b, dil, nblk, band, h, d)

    def with_prev(a):
        prev = jnp.pad(a[:, :, :-1], ((0, 0), (0, 0), (1, 0), (0, 0), (0, 0), (0, 0)))
        return jnp.concatenate([prev, a], axis=3)

    qb = to_blocks(q)
    kk = with_prev(to_blocks(k))
    vv = with_prev(to_blocks(v))
    s = jnp.einsum('brnqhd,brnkhd->brnhqk', qb, kk) * ATT_SCALE
    qi = jnp.arange(band)[:, None]
    kj = jnp.arange(2 * band)[None, :]
    dist = band + qi - kj
    in_band = (dist >= 0) & (dist <= band)
    has_prev = (jnp.arange(nblk)[:, None, None] > 0) | (kj[None] >= band)
    valid = in_band[None] & has_prev
    s = jnp.where(valid[None, None, :, None], s, NEG_INF)
    m = jnp.max(s, axis=-1, keepdims=True)
    p = jnp.exp(s - m)
    den = jnp.sum(p, axis=-1)
    o = jnp.einsum('brnhqk,brnkhd->brnqhd', p, vv) / den.transpose(0, 1, 2, 4, 3)[..., None]
    lse = (m[..., 0] + jnp.log(den)).transpose(0, 1, 2, 4, 3)
    o = o.reshape(b, dil, tp // dil, h, d).transpose(0, 2, 1, 3, 4).reshape(b, tp, h, d)[:, :t]
    lse = lse.reshape(b, dil, tp // dil, h).transpose(0, 2, 1, 3).reshape(b, tp, h)[:, :t]
    return o, lse


def dilated_branch_sample(q, k_all, v_all, window, dil, lb):
    s_len = q.shape[1]
    band = window // dil
    idx = lb + jnp.arange(s_len)[:, None] - dil * jnp.arange(band + 1)[None, :]
    valid = idx >= 0
    idx = jnp.maximum(idx, 0)
    kg = k_all[:, idx].astype(jnp.float32)
    vg = v_all[:, idx].astype(jnp.float32)
    sc = jnp.einsum('bshd,bsjhd->bhsj', q.astype(jnp.float32), kg) * ATT_SCALE
    sc = jnp.where(valid[None, None], sc, NEG_INF)
    m = jnp.max(sc, axis=-1, keepdims=True)
    p = jnp.exp(sc - m)
    den = jnp.sum(p, axis=-1)
    o = jnp.einsum('bhsj,bsjhd->bshd', p, vg) / den.transpose(0, 2, 1)[..., None]
    lse = (m[..., 0] + jnp.log(den)).transpose(0, 2, 1)
    return o, lse


def merge_branches(outs, lses):
    o = jnp.stack(outs, axis=2)
    alpha = jax.nn.softmax(jnp.stack(lses, axis=2), axis=2)
    b, t = o.shape[:2]
    return (o * alpha[..., None]).reshape(b, t, D_ATT)


def attend_prompt(q, k, v):
    t = q.shape[1]
    outs, lses, kv_rows = [], [], []
    for g, (win, dil) in enumerate(ATT_BRANCHES):
        o, l = dilated_branch_prompt(q[:, :, g], k[:, :, g], v[:, :, g], win, dil)
        outs.append(o)
        lses.append(l)
        kv_rows.append(jnp.stack([k[:, :, g], v[:, :, g]], axis=2)[:, t - min(win, t):])
    return merge_branches(outs, lses), kv_rows


def attend_sample(q, k, v, kv_caches):
    s_len = q.shape[1]
    outs, lses, kv_rows = [], [], []
    for g, (win, dil) in enumerate(ATT_BRANCHES):
        cache = kv_caches[g]
        lb = cache.shape[1]
        new_rows = jnp.stack([k[:, :, g], v[:, :, g]], axis=2).astype(cache.dtype)
        kv_all = jnp.concatenate([cache, new_rows], axis=1)
        o, l = dilated_branch_sample(q[:, :, g], kv_all[:, :, 0], kv_all[:, :, 1], win, dil, lb)
        outs.append(o)
        lses.append(l)
        keep = min(win, lb + s_len)
        kv_rows.append(kv_all[:, lb + s_len - keep:])
    return merge_branches(outs, lses), kv_rows


def ssd_scan(xs, dt, a, bm, cm, h0):
    b, t = xs.shape[:2]
    cl = math.gcd(SSD_CHUNK, t)
    nc = t // cl
    G, R, P, N = SSD_GROUPS, SSD_HEADS_PER_GROUP, SSD_HEAD_DIM, SSD_STATE
    x = xs.reshape(b, nc, cl, G, R, P)
    dtc = dt.reshape(b, nc, cl, G, R)
    bc = bm.reshape(b, nc, cl, G, N)
    cc = cm.reshape(b, nc, cl, G, N)
    acum = jnp.cumsum(dtc * a.reshape(G, R), axis=2)
    seg = acum[:, :, :, None] - acum[:, :, None]
    causal = jnp.tril(jnp.ones((cl, cl), dtype=bool))[:, :, None, None]
    lmat = jnp.exp(jnp.where(causal, seg, -jnp.inf))
    cb = jnp.einsum('bclgn,bcsgn->bclsg', cc, bc)
    y_diag = jnp.einsum('bclsgr,bcsgrp->bclgrp', cb[..., None] * lmat * dtc[:, :, None], x)
    decay = jnp.exp(acum[:, :, -1:] - acum)
    states = jnp.einsum('bclgn,bclgr,bclgrp->bcgrpn', bc, decay * dtc, x)
    chunk_decay = jnp.exp(acum[:, :, -1])

    def step(h, inp):
        st, dec = inp
        return dec[..., None, None] * h + st, h

    h_last, h_prev = lax.scan(step, h0.reshape(b, G, R, P, N),
                              (states.transpose(1, 0, 2, 3, 4, 5), chunk_decay.transpose(1, 0, 2, 3)))
    h_prev = h_prev.transpose(1, 0, 2, 3, 4, 5)
    y_off = jnp.einsum('bclgn,bcgrpn,bclgr->bclgrp', cc, h_prev, jnp.exp(acum))
    y = (y_diag + y_off).reshape(b, t, SSD_HEADS, P)
    return y, h_last.reshape(b, SSD_HEADS, P, N)


def ssd_mixer(z, xbc, dt_raw, conv_prev, ssm_prev, conv_w, conv_b, dt_bias, a_log, d_skip, norm_ssd):
    b, t = xbc.shape[:2]
    f32 = jnp.float32
    xpad = jnp.concatenate([conv_prev, xbc.astype(conv_prev.dtype)], axis=1)
    new_conv = xpad[:, -(CONV_WIDTH - 1):]
    xc = lax.conv_general_dilated(xpad.astype(f32), conv_w.astype(f32)[:, None, :], (1,), 'VALID',
                                  dimension_numbers=('NWC', 'WIO', 'NWC'),
                                  feature_group_count=CONV_DIM) + conv_b.astype(f32)
    xc = jax.nn.silu(xc)
    gn = SSD_GROUPS * SSD_STATE
    xs = xc[..., :D_INNER].reshape(b, t, SSD_HEADS, SSD_HEAD_DIM)
    bm = xc[..., D_INNER:D_INNER + gn].reshape(b, t, SSD_GROUPS, SSD_STATE)
    cm = xc[..., D_INNER + gn:].reshape(b, t, SSD_GROUPS, SSD_STATE)
    dt = jax.nn.softplus(dt_raw.astype(f32) + dt_bias.astype(f32))
    a = -jnp.exp(a_log.astype(f32))
    y, h_last = ssd_scan(xs, dt, a, bm, cm, ssm_prev.astype(f32))
    y = y + d_skip.astype(f32)[:, None] * xs
    y = y.reshape(b, t, D_INNER) * jax.nn.silu(z.astype(f32))
    y = rmsnorm(y, norm_ssd)
    return y, new_conv, h_last.astype(ssm_prev.dtype)


def decoder_layer(x, attend, conv_prev, ssm_prev, norm_mix, w_in, conv_w, conv_b, dt_bias, a_log,
                  d_skip, norm_ssd, w_out, norm_ffn, w_gate_up, w_down):
    q, k, v, z, xbc, dt_raw = project(x, norm_mix, w_in)
    att, kv_rows = attend(q, k, v)
    ssd, conv_new, ssm_new = ssd_mixer(z, xbc, dt_raw, conv_prev, ssm_prev, conv_w, conv_b,
                                       dt_bias, a_log, d_skip, norm_ssd)
    mixed = jnp.concatenate([att, ssd], axis=-1).astype(x.dtype)
    h = x + mixed @ w_out
    gu = rmsnorm(h, norm_ffn) @ w_gate_up
    y = h + (jax.nn.silu(gu[..., :D_FF]) * gu[..., D_FF:]) @ w_down
    return y, kv_rows, conv_new, ssm_new


def setup_inputs(seed: int = 0) -> dict:
    key = jax.random.key(seed)
    ks = jax.random.split(key, 20)
    f32 = jnp.float32
    nrm = lambda k, shp, sc=1.0: (jax.random.normal(k, shp, f32) * sc).astype(f32)
    caches = {}
    for i, (win, dil) in enumerate(ATT_BRANCHES):
        caches['cache_kv_d%d' % dil] = nrm(ks[2 + i], (DEPTH, DEC_BATCH, min(win, PAST_LEN), 2,
                                                     HEADS_PER_BRANCH, HEAD_DIM))
    dt0 = jnp.exp(jax.random.uniform(ks[8], (DEPTH, SSD_HEADS), f32,
                                     minval=math.log(1e-3), maxval=math.log(1e-1)))
    return {
        'x_prompt': nrm(ks[0], (BATCH, SEQ, D_MODEL)),
        'x_sample': nrm(ks[1], (DEC_BATCH, DEC_SEQ, D_MODEL)),
        'cache_kv_d1': caches['cache_kv_d1'],
        'cache_kv_d4': caches['cache_kv_d4'],
        'cache_kv_d16': caches['cache_kv_d16'],
        'state_conv': nrm(ks[5], (DEPTH, DEC_BATCH, CONV_WIDTH - 1, CONV_DIM)),
        'state_ssm': nrm(ks[6], (DEPTH, DEC_BATCH, SSD_HEADS, SSD_HEAD_DIM, SSD_STATE), 0.1),
        'norm_mix': 1.0 + nrm(ks[7], (DEPTH, D_MODEL), 0.02),
        'w_in': nrm(ks[9], (DEPTH, D_MODEL, D_IN_TOTAL), D_MODEL ** -0.5),
        'conv_w': nrm(ks[10], (DEPTH, CONV_WIDTH, CONV_DIM), CONV_WIDTH ** -0.5),
        'conv_b': nrm(ks[11], (DEPTH, CONV_DIM), 0.02),
        'dt_bias': dt0 + jnp.log(-jnp.expm1(-dt0)),
        'a_log': jnp.log(jax.random.uniform(ks[12], (DEPTH, SSD_HEADS), f32, minval=1.0, maxval=16.0)),
        'd_skip': 1.0 + nrm(ks[13], (DEPTH, SSD_HEADS), 0.1),
        'norm_ssd': 1.0 + nrm(ks[14], (DEPTH, D_INNER), 0.02),
        'w_out': nrm(ks[15], (DEPTH, D_MIX, D_MODEL), D_MIX ** -0.5),
        'norm_ffn': 1.0 + nrm(ks[16], (DEPTH, D_MODEL), 0.02),
        'w_gate_up': nrm(ks[17], (DEPTH, D_MODEL, 2 * D_FF), D_MODEL ** -0.5),
        'w_down': nrm(ks[18], (DEPTH, D_FF, D_MODEL), D_FF ** -0.5),
        'norm_final': 1.0 + nrm(ks[19], (D_MODEL,), 0.02),
    }


def reference(x_prompt, x_sample, cache_kv_d1, cache_kv_d4, cache_kv_d16, state_conv, state_ssm,
              norm_mix, w_in, conv_w, conv_b, dt_bias, a_log, d_skip, norm_ssd, w_out, norm_ffn,
              w_gate_up, w_down, norm_final):
    hp, hs = x_prompt, x_sample
    p_new = [[] for _ in range(5)]
    s_new = [[] for _ in range(5)]
    for l in range(DEPTH):
        w = (norm_mix[l], w_in[l], conv_w[l], conv_b[l], dt_bias[l], a_log[l], d_skip[l],
             norm_ssd[l], w_out[l], norm_ffn[l], w_gate_up[l], w_down[l])
        conv0 = jnp.zeros((hp.shape[0], CONV_WIDTH - 1, CONV_DIM), hp.dtype)
        ssm0 = jnp.zeros((hp.shape[0], SSD_HEADS, SSD_HEAD_DIM, SSD_STATE), hp.dtype)
        hp, kv_p, conv_p, ssm_p = decoder_layer(hp, attend_prompt, conv0, ssm0, *w)
        caches_l = (cache_kv_d1[l], cache_kv_d4[l], cache_kv_d16[l])
        hs, kv_s, conv_s, ssm_s = decoder_layer(hs, functools.partial(attend_sample, kv_caches=caches_l),
                                                state_conv[l], state_ssm[l], *w)
        for i, arr in enumerate((kv_p[0], kv_p[1], kv_p[2], conv_p, ssm_p)):
            p_new[i].append(arr)
        for i, arr in enumerate((kv_s[0], kv_s[1], kv_s[2], conv_s, ssm_s)):
            s_new[i].append(arr)
    y_prompt = rmsnorm(hp, norm_final)
    y_sample = rmsnorm(hs, norm_final)
    p_kv_d1, p_kv_d4, p_kv_d16, p_conv, p_ssm = [jnp.stack(a) for a in p_new]
    s_kv_d1, s_kv_d4, s_kv_d16, s_conv, s_ssm = [jnp.stack(a) for a in s_new]
    return (y_prompt, y_sample, p_kv_d1, p_kv_d4, p_kv_d16, p_conv, p_ssm,
            s_kv_d1, s_kv_d4, s_kv_d16, s_conv, s_ssm)
```

```cpp
#include <hip/hip_runtime.h>
#include <hip/hip_cooperative_groups.h>
#include <cstdio>
#include <cstdint>
namespace cg = cooperative_groups;
namespace pg8 {
#define PG8_LAS __attribute__((address_space(3)))
typedef unsigned short bf16_t;
typedef short bf16x8 __attribute__((ext_vector_type(8)));
typedef float f32x4 __attribute__((ext_vector_type(4)));
typedef unsigned u32x4 __attribute__((ext_vector_type(4)));
constexpr int BM = 256, BK = 64, HALF = 128, HTB = HALF * BK * 2  , STAGE_BYTES = 8 * HTB, NXCD = 8, WGM = 8;

__host__ __device__ __forceinline__ int lds_byte(int r, int c) { const int st = (r >> 4) * 2 + (c >> 5), rr = r & 15, cc = c & 31, ob = rr * 64 + cc * 2; return st * 1024 + (ob ^ (((ob >> 9) & 1) << 5)); }
__host__ __device__ __forceinline__ void stage_rc(int b, int& R, int& C) { const int st = b / 1024, sb = b % 1024, swz = sb ^ (((sb >> 9) & 1) << 5); R = (st >> 1) * 16 + swz / 64; C = (st & 1) * 32 + (swz % 64) / 2; }
__host__ __device__ __forceinline__ int perm32(int rho) { const int n = rho >> 4, i = rho & 15; return 8 * (i >> 2) + 4 * n + (i & 3); }

struct Unit { int pm, pn; };
struct Gemm { const bf16_t* A; const bf16_t* Bt; int M, N, K; };

struct StaticOrder {
    int nM, nN, nwg, G, c;
    __host__ __device__ __forceinline__ void init(int M, int N, int G_, int c_) { nM = M / BM; nN = N / BM; nwg = nM * nN; G = G_; c = c_; }
    __host__ __device__ __forceinline__ bool next(int i, Unit& u) const {
        const long L = (long)i * G + c; if (L >= nwg) return false;
        int wgid = (int)L; { const int q = nwg / NXCD, r = nwg % NXCD, xcd = wgid % NXCD, off = wgid / NXCD; wgid = (xcd < r ? xcd * (q + 1) : r * (q + 1) + (xcd - r) * q) + off; }
        const int nig = WGM * nN, gid = wgid / nig, fm = gid * WGM, gsz = (nM - fm) < WGM ? (nM - fm) : WGM;
        u.pm = fm + ((wgid % nig) % gsz); u.pn = (wgid % nig) / gsz; return true;
    }
    __device__ __forceinline__ void a_ready(const Unit&) const {}
    __device__ __forceinline__ void done(const Unit&) const {}
};

__device__ __forceinline__ unsigned cvt_pk_bf16(float lo, float hi) { unsigned r; asm volatile("v_cvt_pk_bf16_f32 %0, %1, %2" : "=v"(r) : "v"(lo), "v"(hi)); return r; }
template <class Epi, class Sched, bool ALIGN_EPI = false, bool SP2 = false>
__device__ __forceinline__ void gemm_phase(PG8_LAS unsigned char* lds, const Gemm g, const Sched& S, const Epi& E) {
    int tid_ = threadIdx.x; asm volatile("" : "+v"(tid_));
    const int tid = tid_, wid = __builtin_amdgcn_readfirstlane(tid >> 6), lane = tid & 63, wr = wid >> 2, wc = wid & 3, fr = lane & 15, fq = lane >> 4;
    const int K = g.K, nt = K / BK;
    unsigned voffA[2], voffB[2];
#pragma unroll
    for (int i = 0; i < 2; ++i) { int R, C; stage_rc(tid * 16 + i * 8192, R, C); const int Rb = Epi::PERM ? ((R & ~31) + perm32(R & 31)) : R;
        voffA[i] = (unsigned)(R * K + C) * 2u; voffB[i] = (unsigned)(Rb * K + C) * 2u; }
    const size_t kstep = (size_t)(BK * 2);
    const size_t hstep = (size_t)HALF * K * 2;
    const size_t tstep = 2 * hstep;
    const unsigned ldsw = (unsigned)wid * 1024u;
    const int aoff = lds_byte(wr * 64 + fr, fq * 8), boff = lds_byte(wc * 32 + fr, fq * 8);
#define PG8_SA(b, h) (((b) * 2 + (h)) * HTB)
#define PG8_SB(b, h) ((4 + (b) * 2 + (h)) * HTB)
#define PG8_STAGE(bufoff, gbase, voff) do { _Pragma("unroll") for (int _i = 0; _i < 2; ++_i) \
        __builtin_amdgcn_global_load_lds((const unsigned*)((const char*)(gbase) + (voff)[_i]), (PG8_LAS unsigned*)(lds + (bufoff) + ldsw + _i * 8192), 16, 0, 0); } while (0)
#define PG8_LDA(dst, b, h) do { _Pragma("unroll") for (int m = 0; m < 4; ++m) _Pragma("unroll") for (int k = 0; k < 2; ++k) dst[m][k] = *(const PG8_LAS bf16x8*)(lds + PG8_SA(b, h) + aoff + m * 2048 + k * 1024); } while (0)
#define PG8_LDB(dst, b, h) do { _Pragma("unroll") for (int n = 0; n < 2; ++n) _Pragma("unroll") for (int k = 0; k < 2; ++k) dst[n][k] = *(const PG8_LAS bf16x8*)(lds + PG8_SB(b, h) + boff + n * 2048 + k * 1024); } while (0)
#define PG8_MMA(ai, bj, At, Bt) do { __builtin_amdgcn_s_setprio(1); _Pragma("unroll") for (int m = 0; m < 4; ++m) _Pragma("unroll") for (int n = 0; n < 2; ++n) _Pragma("unroll") for (int k = 0; k < 2; ++k) \
        acc[ai][bj][m][n] = __builtin_amdgcn_mfma_f32_16x16x32_bf16(Bt[n][k], At[m][k], acc[ai][bj][m][n], 0, 0, 0); __builtin_amdgcn_s_setprio(0); } while (0)
#define PG8_WAIT_V(n) asm volatile("s_waitcnt vmcnt(" #n ")" ::: "memory")
#define PG8_WAIT_L(n) asm volatile("s_waitcnt lgkmcnt(" #n ")" ::: "memory")
#define PG8_BAR __builtin_amdgcn_s_barrier()
#define PG8_SCHED __builtin_amdgcn_sched_barrier(0)
    Unit cur, nxt; int ui = 0;
    if (!S.next(0, cur)) return;
    f32x4 acc[2][2][4][2];
#pragma unroll
    for (int a = 0; a < 2; ++a)
#pragma unroll
        for (int b = 0; b < 2; ++b)
#pragma unroll
            for (int m = 0; m < 4; ++m)
#pragma unroll
                for (int n = 0; n < 2; ++n) acc[a][b][m][n] = (f32x4){0.f, 0.f, 0.f, 0.f};
    bf16x8 At[4][2], B0[2][2], B1[2][2];
    const char* cA = (const char*)g.A + (size_t)cur.pm * tstep; const char* cB = (const char*)g.Bt + (size_t)cur.pn * tstep;
    S.a_ready(cur);
    if constexpr (SP2) {
        PG8_STAGE(PG8_SB(0, 0), cB, voffB); PG8_STAGE(PG8_SB(0, 1), cB + hstep, voffB); PG8_STAGE(PG8_SA(0, 0), cA, voffA); PG8_STAGE(PG8_SA(0, 1), cA + hstep, voffA);
        if (wr == 1) PG8_BAR;
        PG8_WAIT_V(2); PG8_BAR;
        PG8_STAGE(PG8_SB(1, 0), cB + kstep, voffB); PG8_STAGE(PG8_SA(1, 0), cA + kstep, voffA); PG8_STAGE(PG8_SB(1, 1), cB + hstep + kstep, voffB);
        PG8_WAIT_V(6); PG8_BAR;
    } else {
        PG8_STAGE(PG8_SB(0, 0), cB, voffB); PG8_STAGE(PG8_SA(0, 0), cA, voffA); PG8_STAGE(PG8_SB(0, 1), cB + hstep, voffB); PG8_STAGE(PG8_SA(0, 1), cA + hstep, voffA);
        if (wr == 1) PG8_BAR;
        PG8_WAIT_V(4); PG8_BAR;
        PG8_STAGE(PG8_SB(1, 0), cB + kstep, voffB); PG8_STAGE(PG8_SA(1, 0), cA + kstep, voffA); PG8_STAGE(PG8_SB(1, 1), cB + hstep + kstep, voffB);
        PG8_WAIT_V(6); PG8_BAR;
    }
    for (;;) {
        const bool has_next = S.next(ui + 1, nxt);
        const char* nA = has_next ? (const char*)g.A + (size_t)nxt.pm * tstep : cA; const char* nB = has_next ? (const char*)g.Bt + (size_t)nxt.pn * tstep : cB;
        for (int t = 0; t < nt; t += 2) {
            const bool last = (t == nt - 2);
            const char* a1 = cA + (size_t)(t + 1) * kstep;
            const char* a2 = last ? nA : cA + (size_t)(t + 2) * kstep; const char* b2 = last ? nB : cB + (size_t)(t + 2) * kstep;
            const char* a3 = a2 + kstep; const char* b3 = b2 + kstep;
            if (last && has_next) S.a_ready(nxt);
            if constexpr (SP2) {
            PG8_LDB(B0, 0, 0); PG8_LDB(B1, 0, 1); PG8_SCHED; PG8_LDA(At, 0, 0); PG8_STAGE(PG8_SA(1, 1), a1 + hstep, voffA);
            PG8_WAIT_V(8); PG8_WAIT_L(0); PG8_BAR; PG8_MMA(0, 0, At, B0); PG8_MMA(0, 1, At, B1); PG8_BAR; PG8_SCHED;
            PG8_LDA(At, 0, 1); PG8_STAGE(PG8_SB(0, 0), b2, voffB); PG8_STAGE(PG8_SB(0, 1), b2 + hstep, voffB); PG8_STAGE(PG8_SA(0, 0), a2, voffA);
            PG8_WAIT_V(8); PG8_WAIT_L(0); PG8_BAR; PG8_MMA(1, 0, At, B0); PG8_MMA(1, 1, At, B1); PG8_BAR; PG8_SCHED;
            PG8_LDB(B0, 1, 0); PG8_LDB(B1, 1, 1); PG8_SCHED; PG8_LDA(At, 1, 0); PG8_STAGE(PG8_SA(0, 1), a2 + hstep, voffA);
            PG8_WAIT_V(8); PG8_WAIT_L(0); PG8_BAR; PG8_MMA(0, 0, At, B0); PG8_MMA(0, 1, At, B1); PG8_BAR; PG8_SCHED;
            PG8_LDA(At, 1, 1); PG8_STAGE(PG8_SB(1, 0), b3, voffB); PG8_STAGE(PG8_SB(1, 1), b3 + hstep, voffB); PG8_STAGE(PG8_SA(1, 0), a3, voffA);
            PG8_WAIT_V(8); PG8_WAIT_L(0); PG8_BAR; PG8_MMA(1, 0, At, B0); PG8_MMA(1, 1, At, B1); PG8_BAR; PG8_SCHED;
            } else {
            PG8_LDB(B0, 0, 0); PG8_SCHED; PG8_LDA(At, 0, 0); PG8_STAGE(PG8_SA(1, 1), a1 + hstep, voffA);
            PG8_WAIT_L(8); PG8_BAR; PG8_WAIT_L(0); PG8_MMA(0, 0, At, B0); PG8_BAR; PG8_SCHED;
            PG8_LDB(B1, 0, 1); PG8_STAGE(PG8_SB(0, 0), b2, voffB);
            PG8_BAR; PG8_WAIT_L(0); PG8_MMA(0, 1, At, B1); PG8_BAR;
            PG8_LDA(At, 0, 1); PG8_STAGE(PG8_SA(0, 0), a2, voffA);
            PG8_BAR; PG8_WAIT_L(0); PG8_MMA(1, 0, At, B0); PG8_BAR; PG8_SCHED;
            PG8_STAGE(PG8_SB(0, 1), b2 + hstep, voffB);
            PG8_WAIT_V(6); PG8_BAR; PG8_MMA(1, 1, At, B1); PG8_BAR;
            PG8_LDB(B0, 1, 0); PG8_SCHED; PG8_LDA(At, 1, 0); PG8_STAGE(PG8_SA(0, 1), a2 + hstep, voffA);
            PG8_WAIT_L(8); PG8_BAR; PG8_WAIT_L(0); PG8_MMA(0, 0, At, B0); PG8_BAR; PG8_SCHED;
            PG8_LDB(B1, 1, 1); PG8_STAGE(PG8_SB(1, 0), b3, voffB);
            PG8_BAR; PG8_WAIT_L(0); PG8_MMA(0, 1, At, B1); PG8_BAR;
            PG8_LDA(At, 1, 1); PG8_STAGE(PG8_SA(1, 0), a3, voffA);
            PG8_BAR; PG8_WAIT_L(0); PG8_MMA(1, 0, At, B0); PG8_BAR; PG8_SCHED;
            PG8_STAGE(PG8_SB(1, 1), b3 + hstep, voffB);
            PG8_WAIT_V(6); PG8_BAR; PG8_MMA(1, 1, At, B1); PG8_BAR;
            }
        }
        if constexpr (ALIGN_EPI) { if (wr == 0) PG8_BAR; }
        if constexpr (!Epi::AFTER_DRAIN) { E(acc, cur, wr, wc, fr, fq); S.done(cur); }
        if (!has_next) break;
#pragma unroll
        for (int a = 0; a < 2; ++a)
#pragma unroll
            for (int b = 0; b < 2; ++b)
#pragma unroll
                for (int m = 0; m < 4; ++m)
#pragma unroll
                    for (int n = 0; n < 2; ++n) acc[a][b][m][n] = (f32x4){0.f, 0.f, 0.f, 0.f};
        cur = nxt; cA = nA; cB = nB; ++ui;
        if constexpr (ALIGN_EPI) { if (wr == 1) PG8_BAR; }
    }
    PG8_WAIT_V(0);
    if constexpr (!ALIGN_EPI) { if (wr == 0) PG8_BAR; }
    PG8_BAR;
    if constexpr (Epi::AFTER_DRAIN) { E.fused(acc, cur, wr, wc, fr, fq, lds, wid, lane); S.done(cur); }
#undef PG8_SA
#undef PG8_SB
#undef PG8_STAGE
#undef PG8_LDA
#undef PG8_LDB
#undef PG8_MMA
#undef PG8_WAIT_V
#undef PG8_WAIT_L
#undef PG8_BAR
#undef PG8_SCHED
}
}

#define LAS __attribute__((address_space(3)))
typedef unsigned short bf16;
typedef float f32x4 __attribute__((ext_vector_type(4)));
typedef short bf16x8 __attribute__((ext_vector_type(8)));
typedef unsigned u32x4 __attribute__((ext_vector_type(4)));
typedef unsigned u32x2 __attribute__((ext_vector_type(2)));

constexpr int DM = 1024, NB = 4, SEQ = 4096, MP = NB * SEQ, DB = 128, DSQ = 4, MS = DB * DSQ, M = MP + MS;
constexpr int DATT = 768, DINNER = 768, CONVD = 1792, NIN = 4864, NINTOT = 4876, DMIX = 1536, DFF = 2816, NGU = 5632;
constexpr int NH = 12, NCH = 32;
constexpr float EPS = 1e-5f, ATT_SCALE = 0.125f, LOG2E = 1.4426950408889634f, LN2 = 0.6931471805599453f;

constexpr size_t O_YP = 0, O_YS = O_YP + (size_t)MP * DM, O_PKV1 = O_YS + (size_t)MS * DM, O_PKV4 = O_PKV1 + (size_t)NB * 128 * 512, O_PKV16 = O_PKV4 + (size_t)NB * 512 * 512,
                 O_PCONV = O_PKV16 + (size_t)NB * 2048 * 512, O_PSSM = O_PCONV + (size_t)NB * 3 * CONVD, O_SKV1 = O_PSSM + (size_t)NB * NH * 64 * 128, O_SKV4 = O_SKV1 + (size_t)DB * 128 * 512,
                 O_SKV16 = O_SKV4 + (size_t)DB * 512 * 512, O_SCONV = O_SKV16 + (size_t)DB * 2048 * 512, O_SSSM = O_SCONV + (size_t)DB * 3 * CONVD, O_END = O_SSSM + (size_t)DB * NH * 64 * 128;
static_assert(O_YS == (size_t)MP * DM, "y rows contiguous");

constexpr size_t al256(size_t x) { return (x + 255) & ~(size_t)255; }
constexpr size_t WS_CTL = 0, CTL_BYTES = 65536;
constexpr size_t WS_WIN = CTL_BYTES;
constexpr size_t WS_WO = al256(WS_WIN + (size_t)NIN * DM * 2);
constexpr size_t WS_WGU = al256(WS_WO + (size_t)DM * DMIX * 2);
constexpr size_t WS_WD = al256(WS_WGU + (size_t)NGU * DM * 2);
constexpr size_t WS_XN = al256(WS_WD + (size_t)DM * DFF * 2);
constexpr size_t WS_DT = al256(WS_XN + (size_t)M * DM * 2);
constexpr size_t WS_Q = al256(WS_DT + (size_t)M * 12 * 4);
constexpr size_t WS_K = al256(WS_Q + (size_t)NB * 12 * SEQ * 64 * 2);
constexpr size_t WS_V = al256(WS_K + (size_t)NB * 12 * SEQ * 64 * 2);
constexpr size_t WS_QS = al256(WS_V + (size_t)NB * 12 * SEQ * 64 * 2);
constexpr size_t WS_Z = al256(WS_QS + (size_t)MS * DATT * 4);
constexpr size_t WS_XBC = al256(WS_Z + (size_t)M * DINNER * 2);
constexpr size_t WS_MIX = al256(WS_XBC + (size_t)M * CONVD * 2);
constexpr size_t WS_LSE = al256(WS_MIX + (size_t)M * DMIX * 2);
constexpr size_t WS_SLOC = al256(WS_LSE + (size_t)M * 12 * 4);
constexpr size_t WS_HPREV = al256(WS_SLOC + (size_t)NB * NCH * NH * 64 * 128 * 4);
constexpr size_t WS_CD = al256(WS_HPREV + (size_t)NB * NCH * NH * 64 * 128 * 2);
constexpr size_t WS_H = al256(WS_CD + (size_t)NB * NCH * NH * 4);
constexpr size_t WS_ACT = al256(WS_H + (size_t)M * DM * 4);
constexpr size_t WS_SS1 = al256(WS_ACT + (size_t)M * DFF * 2);
constexpr size_t WS_SS2 = al256(WS_SS1 + (size_t)M * 4);
constexpr size_t WS_XC = al256(WS_SS2 + (size_t)M * 4);
constexpr size_t WS_END = al256(WS_XC + (size_t)MP * CONVD * 2);

constexpr int BAR_LDS_OFF = 139264;
constexpr int LDS_BYTES = 147456;

typedef float f32x2_t __attribute__((ext_vector_type(2)));
typedef __bf16 bf16x2_t __attribute__((ext_vector_type(2)));
__device__ __forceinline__ unsigned cvtpk(float lo, float hi) { f32x2_t v = {lo, hi}; bf16x2_t b = __builtin_convertvector(v, bf16x2_t); return __builtin_bit_cast(unsigned, b); }
__device__ __forceinline__ float bflo(unsigned u) { return __uint_as_float(u << 16); }
__device__ __forceinline__ float bfhi(unsigned u) { return __uint_as_float(u & 0xffff0000u); }
__device__ __forceinline__ float bf2f(bf16 h) { return __uint_as_float((unsigned)h << 16); }
__device__ __forceinline__ float silu_f(float x) { return x / (1.0f + __expf(-x)); }
__device__ __forceinline__ float softplus_f(float x) { return x > 20.f ? x : log1pf(__expf(x)); }
__device__ __forceinline__ float wave_sum(float v) {
#pragma unroll
    for (int o = 1; o < 64; o <<= 1) v += __shfl_xor(v, o);
    return v;
}
__device__ __forceinline__ float wave_max(float v) {
#pragma unroll
    for (int o = 1; o < 64; o <<= 1) v = fmaxf(v, __shfl_xor(v, o));
    return v;
}
#define LDS_WAIT() asm volatile("s_waitcnt lgkmcnt(0)" ::: "memory")
__device__ __forceinline__ f32x4 mfma16(bf16x8 a, bf16x8 b, f32x4 c) { return __builtin_amdgcn_mfma_f32_16x16x32_bf16(a, b, c, 0, 0, 0); }
__device__ __forceinline__ bf16x8 mk8(unsigned a, unsigned b, unsigned c, unsigned d) { u32x4 v = {a, b, c, d}; return __builtin_bit_cast(bf16x8, v); }
__device__ __forceinline__ float dot4(f32x4 a, f32x4 b) { return (a.x * b.x + a.y * b.y) + (a.z * b.z + a.w * b.w); }

struct Params {
    const float* in[20];
    float* out;
    unsigned char* ws;
};
enum { I_XP = 0, I_XS, I_C1, I_C4, I_C16, I_SCONV, I_SSSM, I_NMIX, I_WIN, I_CW, I_CB, I_DTB, I_ALOG, I_DSKIP, I_NSSD, I_WOUT, I_NFFN, I_WGU, I_WD, I_NFIN };

struct EpiIn {
    static constexpr bool PERM = true, AFTER_DRAIN = false;
    bf16 *Q, *K, *V, *Z, *XBC; float* QS; float* out;
    __device__ __forceinline__ void operator()(const f32x4 (&acc)[2][2][4][2], const pg8::Unit& u, int wr, int wc, int fr, int fq) const {
        const int pn = u.pn; const bool sample = u.pm >= MP / 256;
#pragma unroll
        for (int ai = 0; ai < 2; ++ai)
#pragma unroll
            for (int m = 0; m < 4; ++m) {
                const int row = u.pm * 256 + ai * 128 + wr * 64 + m * 16 + fr;
#pragma unroll
                for (int bj = 0; bj < 2; ++bj) {
                    const int c0 = bj * 128 + wc * 32 + 8 * fq;
                    f32x4 v0 = acc[ai][bj][m][0], v1 = acc[ai][bj][m][1];
                    if (pn < 9) {
                        const int kind = pn / 3, g = pn % 3, j = c0 >> 6, d0 = c0 & 63, sh = 2 * g, win = 128 << sh;
                        if (!sample) {
                            const int b = row >> 12, t = row & 4095;
                            const int perm = (t & ((1 << sh) - 1)) * (SEQ >> sh) + (t >> sh);
                            const size_t off = ((size_t)((b * 3 + g) * 4 + j) * SEQ + perm) * 64 + d0;
                            if (kind == 0) { v0 = v0 * (ATT_SCALE * LOG2E); v1 = v1 * (ATT_SCALE * LOG2E); }
                            u32x4 w; w.x = cvtpk(v0[0], v0[1]); w.y = cvtpk(v0[2], v0[3]); w.z = cvtpk(v1[0], v1[1]); w.w = cvtpk(v1[2], v1[3]);
                            bf16* dst = kind == 0 ? Q : (kind == 1 ? K : V);
                            *(u32x4*)(dst + off) = w;
                            if (kind != 0 && t >= SEQ - win) {
                                const size_t ob = (g == 0 ? O_PKV1 : (g == 1 ? O_PKV4 : O_PKV16));
                                float* o = out + ob + ((((size_t)b * win + (t - (SEQ - win))) * 2 + (kind - 1)) * 4 + j) * 64 + d0;
                                *(f32x4*)o = acc[ai][bj][m][0]; *(f32x4*)(o + 4) = acc[ai][bj][m][1];
                            }
                        } else {
                            const int rs = row - MP, b = rs >> 2, s = rs & 3;
                            if (kind == 0) { float* o = QS + (size_t)rs * DATT + g * 256 + c0; *(f32x4*)o = v0; *(f32x4*)(o + 4) = v1; }
                            else {
                                const size_t ob = (g == 0 ? O_SKV1 : (g == 1 ? O_SKV4 : O_SKV16));
                                float* o = out + ob + ((((size_t)b * win + (win - 4 + s)) * 2 + (kind - 1)) * 4 + j) * 64 + d0;
                                *(f32x4*)o = v0; *(f32x4*)(o + 4) = v1;
                            }
                        }
                    } else {
                        u32x4 w; w.x = cvtpk(v0[0], v0[1]); w.y = cvtpk(v0[2], v0[3]); w.z = cvtpk(v1[0], v1[1]); w.w = cvtpk(v1[2], v1[3]);
                        if (pn < 12) { *(u32x4*)(Z + (size_t)row * DINNER + (pn - 9) * 256 + c0) = w; }
                        else {
                            const int col = (pn - 12) * 256 + c0;
                            *(u32x4*)(XBC + (size_t)row * CONVD + col) = w;
                            if (!sample) { const int b = row >> 12, t = row & 4095;
                                if (t >= SEQ - 3) { float* o = out + O_PCONV + ((size_t)b * 3 + (t - (SEQ - 3))) * CONVD + col; *(f32x4*)o = v0; *(f32x4*)(o + 4) = v1; } }
                            else { const int rs = row - MP, b = rs >> 2, s = rs & 3;
                                if (s >= 1) { float* o = out + O_SCONV + ((size_t)b * 3 + (s - 1)) * CONVD + col; *(f32x4*)o = v0; *(f32x4*)(o + 4) = v1; } }
                        }
                    }
                }
            }
    }
};

struct EpiOut {
    static constexpr bool PERM = false, AFTER_DRAIN = false;
    const float *xp, *xs, *gffn; float* H; bf16* HG; float* SS1;
    __device__ __forceinline__ void operator()(const f32x4 (&acc)[2][2][4][2], const pg8::Unit& u, int wr, int wc, int fr, int fq) const {
        const int colb = u.pn * 256 + wc * 32 + 4 * fq;
        f32x4 gv[2][2];
#pragma unroll
        for (int bj = 0; bj < 2; ++bj)
#pragma unroll
            for (int n = 0; n < 2; ++n) gv[bj][n] = *(const f32x4*)(gffn + colb + bj * 128 + n * 16);
#pragma unroll
        for (int ai = 0; ai < 2; ++ai) {
            f32x4 xv[4][2][2];
#pragma unroll
            for (int m = 0; m < 4; ++m) {
                const int row = u.pm * 256 + ai * 128 + wr * 64 + m * 16 + fr;
                const float* xrow = row < MP ? xp + (size_t)row * DM : xs + (size_t)(row - MP) * DM;
#pragma unroll
                for (int bj = 0; bj < 2; ++bj)
#pragma unroll
                    for (int n = 0; n < 2; ++n) xv[m][bj][n] = *(const f32x4*)(xrow + colb + bj * 128 + n * 16);
            }
#pragma unroll
            for (int m = 0; m < 4; ++m) {
                const int row = u.pm * 256 + ai * 128 + wr * 64 + m * 16 + fr;
                float ss = 0.f;
#pragma unroll
                for (int bj = 0; bj < 2; ++bj)
#pragma unroll
                    for (int n = 0; n < 2; ++n) {
                        const int col = colb + bj * 128 + n * 16;
                        const f32x4 hv = xv[m][bj][n] + acc[ai][bj][m][n];
                        *(f32x4*)(H + (size_t)row * DM + col) = hv; ss += dot4(hv, hv);
                        const f32x4 o = hv * gv[bj][n];
                        u32x2 w; w.x = cvtpk(o[0], o[1]); w.y = cvtpk(o[2], o[3]);
                        *(u32x2*)(HG + (size_t)row * DM + col) = w;
                    }
                ss += __shfl_xor(ss, 16); ss += __shfl_xor(ss, 32);
                if (fq == 0) atomicAdd(SS1 + row, ss);
            }
        }
    }
};

struct EpiGU {
    static constexpr bool PERM = true, AFTER_DRAIN = false;
    const float* SS1; bf16* ACT;
    __device__ __forceinline__ void operator()(const f32x4 (&acc)[2][2][4][2], const pg8::Unit& u, int wr, int wc, int fr, int fq) const {
#pragma unroll
        for (int ai = 0; ai < 2; ++ai)
#pragma unroll
            for (int m = 0; m < 4; ++m) {
                const int row = u.pm * 256 + ai * 128 + wr * 64 + m * 16 + fr;
                const float r = rsqrtf(SS1[row] * (1.0f / DM) + EPS);
#pragma unroll
                for (int bj = 0; bj < 2; ++bj) {
                    const int c0 = u.pn * 256 + bj * 128 + wc * 32 + 8 * fq;
                    const f32x4 gt = acc[ai][bj][m][0] * r, up = acc[ai][bj][m][1] * r;
                    f32x4 a; a.x = silu_f(gt.x) * up.x; a.y = silu_f(gt.y) * up.y; a.z = silu_f(gt.z) * up.z; a.w = silu_f(gt.w) * up.w;
                    u32x2 w; w.x = cvtpk(a[0], a[1]); w.y = cvtpk(a[2], a[3]);
                    *(u32x2*)(ACT + (size_t)row * DFF + (c0 >> 1)) = w;
                }
            }
    }
};

struct EpiDown {
    static constexpr bool PERM = false, AFTER_DRAIN = false;
    const float* H; float* Y; float* SS2;
    __device__ __forceinline__ void operator()(const f32x4 (&acc)[2][2][4][2], const pg8::Unit& u, int wr, int wc, int fr, int fq) const {
        const int colb = u.pn * 256 + wc * 32 + 4 * fq;
#pragma unroll
        for (int ai = 0; ai < 2; ++ai) {
            f32x4 hv[4][2][2];
#pragma unroll
            for (int m = 0; m < 4; ++m) {
                const int row = u.pm * 256 + ai * 128 + wr * 64 + m * 16 + fr;
#pragma unroll
                for (int bj = 0; bj < 2; ++bj)
#pragma unroll
                    for (int n = 0; n < 2; ++n) hv[m][bj][n] = *(const f32x4*)(H + (size_t)row * DM + colb + bj * 128 + n * 16);
            }
#pragma unroll
            for (int m = 0; m < 4; ++m) {
                const int row = u.pm * 256 + ai * 128 + wr * 64 + m * 16 + fr;
                float ss = 0.f;
#pragma unroll
                for (int bj = 0; bj < 2; ++bj)
#pragma unroll
                    for (int n = 0; n < 2; ++n) {
                        const f32x4 yv = hv[m][bj][n] + acc[ai][bj][m][n];
                        *(f32x4*)(Y + (size_t)row * DM + colb + bj * 128 + n * 16) = yv; ss += dot4(yv, yv);
                    }
                ss += __shfl_xor(ss, 16); ss += __shfl_xor(ss, 32);
                if (fq == 0) atomicAdd(SS2 + row, ss);
            }
        }
    }
};

__device__ __forceinline__ int gu_map(int n) { return n < DFF ? ((n >> 2) << 3) + (n & 3) : (((n - DFF) >> 2) << 3) + 4 + ((n - DFF) & 3); }

__device__ __forceinline__ void transpose_item(const float* __restrict__ W, int K, int ldn, int nblk, bf16* __restrict__ WT, int mode, LAS float* scr, int item, int lane) {
    const int kb = item / nblk, nb = item % nblk, k0 = 64 * kb, n0 = 32 * nb;
    float tv[32];
#pragma unroll
    for (int i = 0; i < 32; ++i) { const int kk = 2 * i + (lane >> 5); tv[i] = W[(size_t)(k0 + kk) * ldn + n0 + (lane & 31)]; }
#pragma unroll
    for (int i = 0; i < 32; ++i) { const int kk = 2 * i + (lane >> 5); scr[kk * 33 + (lane & 31)] = tv[i]; }
    LDS_WAIT();
    const int c = lane & 7;
#pragma unroll
    for (int j = 0; j < 4; ++j) { const int n = (lane >> 3) + 8 * j; const LAS float* s = scr + (8 * c) * 33 + n;
        u32x4 o; o.x = cvtpk(s[0 * 33], s[1 * 33]); o.y = cvtpk(s[2 * 33], s[3 * 33]); o.z = cvtpk(s[4 * 33], s[5 * 33]); o.w = cvtpk(s[6 * 33], s[7 * 33]);
        const int row = mode ? gu_map(n0 + n) : (n0 + n);
        *(u32x4*)(WT + (size_t)row * K + k0 + 8 * c) = o; }
    LDS_WAIT();
}

__device__ __forceinline__ void p0_prologue(const Params& P, LAS unsigned char* lds, int tid, int wave, int lane, int G) {
    unsigned char* ws = P.ws;
    LAS float* wdt = (LAS float*)lds;
    LAS float* scr = (LAS float*)(lds + 49152 + wave * 8704);
    const float* w_in = P.in[I_WIN];
    for (int i = tid; i < DM * 12; i += 512) { const int col = i / 12, h = i % 12; wdt[i] = w_in[(size_t)col * NINTOT + NIN + h]; }
    {
        float* ss1 = (float*)(ws + WS_SS1); float* ss2 = (float*)(ws + WS_SS2);
        for (int i = blockIdx.x * 512 + tid; i < M; i += G * 512) { ss1[i] = 0.f; ss2[i] = 0.f; }
    }
    const int gw = blockIdx.x * 8 + wave, NGW = G * 8;
    constexpr int I_IN = (DM / 64) * (NIN / 32), I_O = (DMIX / 64) * (DM / 32), I_GU = (DM / 64) * (NGU / 32), I_D = (DFF / 64) * (DM / 32);
#pragma unroll 1
    for (int it = gw; it < I_IN + I_O + I_GU + I_D; it += NGW) {
        int r = it;
        if (r < I_IN) { transpose_item(w_in, DM, NINTOT, NIN / 32, (bf16*)(ws + WS_WIN), 0, scr, r, lane); continue; } r -= I_IN;
        if (r < I_O) { transpose_item(P.in[I_WOUT], DMIX, DM, DM / 32, (bf16*)(ws + WS_WO), 0, scr, r, lane); continue; } r -= I_O;
        if (r < I_GU) { transpose_item(P.in[I_WGU], DM, NGU, NGU / 32, (bf16*)(ws + WS_WGU), 1, scr, r, lane); continue; } r -= I_GU;
        transpose_item(P.in[I_WD], DFF, DM, DM / 32, (bf16*)(ws + WS_WD), 0, scr, r, lane);
    }
    __syncthreads();
    const float* gmix = P.in[I_NMIX]; const float* dtb = P.in[I_DTB];
    bf16* XN = (bf16*)(ws + WS_XN); float* DT = (float*)(ws + WS_DT);
    f32x4 nv[4];
    if (gw < M) { const float* xr0 = gw < MP ? P.in[I_XP] + (size_t)gw * DM : P.in[I_XS] + (size_t)(gw - MP) * DM;
#pragma unroll
        for (int j = 0; j < 4; ++j) nv[j] = ((const f32x4*)xr0)[lane + 64 * j]; }
#pragma unroll 1
    for (int row = gw; row < M; row += NGW) {
        f32x4 v[4]; float ss = 0.f;
#pragma unroll
        for (int j = 0; j < 4; ++j) { v[j] = nv[j]; ss += dot4(v[j], v[j]); }
        { const int nr = row + NGW;
          if (nr < M) { const float* xr1 = nr < MP ? P.in[I_XP] + (size_t)nr * DM : P.in[I_XS] + (size_t)(nr - MP) * DM;
#pragma unroll
            for (int j = 0; j < 4; ++j) nv[j] = ((const f32x4*)xr1)[lane + 64 * j]; } }
        const float inv = rsqrtf(wave_sum(ss) * (1.0f / DM) + EPS);
        float pd[12];
#pragma unroll
        for (int h = 0; h < 12; ++h) pd[h] = 0.f;
#pragma unroll
        for (int j = 0; j < 4; ++j) {
            const f32x4 gv = ((const f32x4*)gmix)[lane + 64 * j];
            v[j] = v[j] * inv * gv;
            u32x2 w; w.x = cvtpk(v[j][0], v[j][1]); w.y = cvtpk(v[j][2], v[j][3]);
            *(u32x2*)(XN + (size_t)row * DM + 4 * (lane + 64 * j)) = w;
#pragma unroll
            for (int e = 0; e < 4; ++e) {
                const LAS f32x4* wp = (const LAS f32x4*)(wdt + (4 * (lane + 64 * j) + e) * 12);
                const f32x4 w0 = wp[0], w1 = wp[1], w2 = wp[2]; const float xv = v[j][e];
                pd[0] += xv * w0.x; pd[1] += xv * w0.y; pd[2] += xv * w0.z; pd[3] += xv * w0.w;
                pd[4] += xv * w1.x; pd[5] += xv * w1.y; pd[6] += xv * w1.z; pd[7] += xv * w1.w;
                pd[8] += xv * w2.x; pd[9] += xv * w2.y; pd[10] += xv * w2.z; pd[11] += xv * w2.w;
            }
            __builtin_amdgcn_sched_barrier(0);
        }
        float mine = 0.f;
#pragma unroll
        for (int h = 0; h < 12; ++h) { const float s = wave_sum(pd[h]); if (lane == h) mine = s; }
        if (lane < 12) DT[(size_t)row * 12 + lane] = softplus_f(mine + dtb[lane]);
    }
    __syncthreads();
}

__device__ __forceinline__ void attn_item(LAS unsigned char* lds, int item, const bf16* __restrict__ Qp, const bf16* __restrict__ Kp, const bf16* __restrict__ Vp,
                                          bf16* __restrict__ mixed, float* __restrict__ lse, int tid, int wave, int lane) {
    const int blk = item & 31, j = (item >> 5) & 3, g = (item >> 7) % 3, b = item / 384;
    const int sh = 2 * g, per_class = SEQ >> sh, nbc = per_class >> 7;
    const bool first = (blk & (nbc - 1)) == 0;
    const size_t headbase = (size_t)((b * 3 + g) * 4 + j) * SEQ * 64;
    const int fr = lane & 15, fq = lane >> 4;
    LAS unsigned char* Kl = lds;
    LAS bf16* Vt = (LAS bf16*)(lds + 36864);
    __syncthreads();
    {
        const bf16* Kb = Kp + headbase + ((size_t)blk * 128) * 64 - 128 * 64;
        const bf16* Vb = Vp + headbase + ((size_t)blk * 128) * 64 - 128 * 64;
#pragma unroll
        for (int i = 0; i < 4; ++i) {
            const int ci = tid + 512 * i, row = ci >> 3, c8 = ci & 7;
            u32x4 val = {0u, 0u, 0u, 0u};
            if (!(first && row < 128)) val = *(const u32x4*)(Kb + (size_t)row * 64 + c8 * 8);
            *(LAS u32x4*)(Kl + row * 144 + c8 * 16) = val;
        }
#pragma unroll
        for (int i = 0; i < 4; ++i) {
            const int row = lane + 64 * i, c8 = wave;
            u32x4 val = {0u, 0u, 0u, 0u};
            if (!(first && row < 128)) val = *(const u32x4*)(Vb + (size_t)row * 64 + c8 * 8);
            LAS bf16* d = Vt + (c8 * 8) * 264 + row;
            d[0 * 264] = (bf16)(val.x & 0xffff); d[1 * 264] = (bf16)(val.x >> 16);
            d[2 * 264] = (bf16)(val.y & 0xffff); d[3 * 264] = (bf16)(val.y >> 16);
            d[4 * 264] = (bf16)(val.z & 0xffff); d[5 * 264] = (bf16)(val.z >> 16);
            d[6 * 264] = (bf16)(val.w & 0xffff); d[7 * 264] = (bf16)(val.w >> 16);
        }
    }
    const bf16* Qb = Qp + headbase + (size_t)(blk * 128 + 16 * wave + fr) * 64;
    const bf16x8 qf0 = *(const bf16x8*)(Qb + fq * 8), qf1 = *(const bf16x8*)(Qb + 32 + fq * 8);
    __syncthreads();
    const int t0 = wave < 6 ? wave : 6;
    f32x4 s[10];
#pragma unroll
    for (int ti = 0; ti < 10; ++ti) {
        const int t = t0 + ti;
        const bf16x8 k0 = *(const LAS bf16x8*)(Kl + (t * 16 + fr) * 144 + fq * 16), k1 = *(const LAS bf16x8*)(Kl + (t * 16 + fr) * 144 + 64 + fq * 16);
        f32x4 a = {0.f, 0.f, 0.f, 0.f};
        a = mfma16(k0, qf0, a); a = mfma16(k1, qf1, a); s[ti] = a;
    }
    const int qi = 16 * wave + fr;
    float mx = -1e30f;
#pragma unroll
    for (int ti = 0; ti < 10; ++ti)
#pragma unroll
        for (int jj = 0; jj < 4; ++jj) {
            const int kj = (t0 + ti) * 16 + fq * 4 + jj, dist = 128 + qi - kj;
            const bool valid = dist >= 0 && dist <= 128 && (!first || kj >= 128);
            const float v = valid ? s[ti][jj] : -1e30f; s[ti][jj] = v; mx = fmaxf(mx, v);
        }
    mx = fmaxf(mx, __shfl_xor(mx, 16)); mx = fmaxf(mx, __shfl_xor(mx, 32));
    float den = 0.f;
#pragma unroll
    for (int ti = 0; ti < 10; ++ti)
#pragma unroll
        for (int jj = 0; jj < 4; ++jj) { const float p = exp2f(s[ti][jj] - mx); s[ti][jj] = p; den += p; }
    den += __shfl_xor(den, 16); den += __shfl_xor(den, 32);
    const float rden = 1.0f / den;
    f32x4 o[4];
#pragma unroll
    for (int dt = 0; dt < 4; ++dt) {
        f32x4 a = {0.f, 0.f, 0.f, 0.f};
#pragma unroll
        for (int i = 0; i < 5; ++i) {
            const LAS bf16* vr = Vt + (dt * 16 + fr) * 264 + (t0 + 2 * i) * 16 + fq * 4;
            const u32x2 lo = *(const LAS u32x2*)vr, hi = *(const LAS u32x2*)(vr + 16);
            const bf16x8 pf = mk8(cvtpk(s[2 * i][0], s[2 * i][1]), cvtpk(s[2 * i][2], s[2 * i][3]), cvtpk(s[2 * i + 1][0], s[2 * i + 1][1]), cvtpk(s[2 * i + 1][2], s[2 * i + 1][3]));
            a = mfma16(mk8(lo.x, lo.y, hi.x, hi.y), pf, a);
        }
        o[dt] = a * rden;
    }
    const int pp = blk * 128 + qi, cls = pp >> (12 - sh), ii = pp & (per_class - 1), pos = (ii << sh) + cls;
    const size_t row = (size_t)b * SEQ + pos;
#pragma unroll
    for (int dt = 0; dt < 4; ++dt) {
        u32x2 w; w.x = cvtpk(o[dt][0], o[dt][1]); w.y = cvtpk(o[dt][2], o[dt][3]);
        *(u32x2*)(mixed + row * DMIX + g * 256 + j * 64 + dt * 16 + fq * 4) = w;
    }
    if (fq == 0) lse[row * 12 + g * 4 + j] = (mx + log2f(den)) * LN2;
}

__device__ __forceinline__ void conv8(const bf16* __restrict__ xb, int t, int col, const float* __restrict__ cw, const float* __restrict__ cb, f32x4& lo, f32x4& hi) {
    f32x4 a0 = *(const f32x4*)(cb + col), a1 = *(const f32x4*)(cb + col + 4);
#pragma unroll
    for (int w = 0; w < 4; ++w) {
        const int tt = t - 3 + w;
        if (tt >= 0) {
            const u32x4 raw = *(const u32x4*)(xb + (size_t)tt * CONVD + col);
            const f32x4 w0 = *(const f32x4*)(cw + w * CONVD + col), w1 = *(const f32x4*)(cw + w * CONVD + col + 4);
            a0.x += bflo(raw.x) * w0.x; a0.y += bfhi(raw.x) * w0.y; a0.z += bflo(raw.y) * w0.z; a0.w += bfhi(raw.y) * w0.w;
            a1.x += bflo(raw.z) * w1.x; a1.y += bfhi(raw.z) * w1.y; a1.z += bflo(raw.w) * w1.z; a1.w += bfhi(raw.w) * w1.w;
        }
    }
    lo.x = silu_f(a0.x); lo.y = silu_f(a0.y); lo.z = silu_f(a0.z); lo.w = silu_f(a0.w);
    hi.x = silu_f(a1.x); hi.y = silu_f(a1.y); hi.z = silu_f(a1.z); hi.w = silu_f(a1.w);
}

__device__ __forceinline__ void scan128(float v0, float v1, int lane, float& i0, float& i1, float& total) {
    float s = v0 + v1;
#pragma unroll
    for (int o = 1; o < 64; o <<= 1) { const float t = __shfl_up(s, o); if (lane >= o) s += t; }
    i1 = s; i0 = s - v1; total = __shfl(s, 63);
}

__device__ __forceinline__ void ssd_passA_item(LAS unsigned char* lds, int item, const Params& P, int tid, int wave, int lane) {
    const int g = item & 3, c = (item >> 2) & 31, b = item >> 7;
    unsigned char* ws = P.ws;
    const bf16* xb = (const bf16*)(ws + WS_XBC) + (size_t)b * SEQ * CONVD;
    bf16* xcb = (bf16*)(ws + WS_XC) + (size_t)b * SEQ * CONVD;
    const float* DT = (const float*)(ws + WS_DT);
    float* SLOC = (float*)(ws + WS_SLOC); float* CD = (float*)(ws + WS_CD);
    const float* cw = P.in[I_CW]; const float* cb = P.in[I_CB];
    LAS float* tabw = (LAS float*)lds;
    LAS bf16* xT = (LAS bf16*)(lds + 2048);
    LAS bf16* BT = (LAS bf16*)(lds + 2048 + 52224);
    const int fr = lane & 15, fq = lane >> 4;
    const int oct = tid % 56, seg = tid / 56, l0 = seg * 16;
    const int col = oct < 24 ? g * 192 + oct * 8 : (oct < 40 ? DINNER + g * 128 + (oct - 24) * 8 : DINNER + 512 + g * 128 + (oct - 40) * 8);
    const int t0 = c * 128 + l0;
    __syncthreads();
    if (wave < 3) {
        const int h = g * 3 + wave; const float a = -__expf(P.in[I_ALOG][h]);
        const size_t r0 = (size_t)b * SEQ + c * 128 + 2 * lane;
        const float d0 = DT[r0 * 12 + h], d1 = DT[(r0 + 1) * 12 + h];
        float i0, i1, tot; scan128(d0 * a, d1 * a, lane, i0, i1, tot);
        tabw[wave * 128 + 2 * lane] = __expf(tot - i0) * d0; tabw[wave * 128 + 2 * lane + 1] = __expf(tot - i1) * d1;
        if (lane == 0) CD[(b * NCH + c) * NH + h] = __expf(tot);
    }
    __syncthreads();
    if (tid < 448) {
        f32x4 wv[4][2], bias[2];
#pragma unroll
        for (int w = 0; w < 4; ++w) { wv[w][0] = *(const f32x4*)(cw + w * CONVD + col); wv[w][1] = *(const f32x4*)(cw + w * CONVD + col + 4); }
        bias[0] = *(const f32x4*)(cb + col); bias[1] = *(const f32x4*)(cb + col + 4);
        const int hh = oct >> 3;
        LAS bf16* dT = oct < 24 ? xT + (hh * 64 + (oct & 7) * 8) * 136 + l0 : BT + ((oct - 24) * 8) * 136 + l0;
#pragma unroll 1
        for (int half = 0; half < 4; ++half) {
            const int th = t0 + 4 * half;
            u32x4 raw[7];
#pragma unroll
            for (int r = 0; r < 7; ++r) { const int tt = th - 3 + r; raw[r] = (u32x4){0u, 0u, 0u, 0u}; if (tt >= 0) raw[r] = *(const u32x4*)(xb + (size_t)tt * CONVD + col); }
#pragma unroll
            for (int lp = 0; lp < 2; ++lp) {
                f32x4 o[2][2];
#pragma unroll
                for (int q = 0; q < 2; ++q) {
                    f32x4 a0 = bias[0], a1 = bias[1];
#pragma unroll
                    for (int w = 0; w < 4; ++w) {
                        const u32x4 r = raw[2 * lp + q + w];
                        a0.x += bflo(r.x) * wv[w][0].x; a0.y += bfhi(r.x) * wv[w][0].y; a0.z += bflo(r.y) * wv[w][0].z; a0.w += bfhi(r.y) * wv[w][0].w;
                        a1.x += bflo(r.z) * wv[w][1].x; a1.y += bfhi(r.z) * wv[w][1].y; a1.z += bflo(r.w) * wv[w][1].z; a1.w += bfhi(r.w) * wv[w][1].w;
                    }
                    o[q][0] = (f32x4){silu_f(a0.x), silu_f(a0.y), silu_f(a0.z), silu_f(a0.w)};
                    o[q][1] = (f32x4){silu_f(a1.x), silu_f(a1.y), silu_f(a1.z), silu_f(a1.w)};
                    u32x4 w4; w4.x = cvtpk(o[q][0].x, o[q][0].y); w4.y = cvtpk(o[q][0].z, o[q][0].w); w4.z = cvtpk(o[q][1].x, o[q][1].y); w4.w = cvtpk(o[q][1].z, o[q][1].w);
                    *(u32x4*)(xcb + (size_t)(th + 2 * lp + q) * CONVD + col) = w4;
                }
                if (oct < 40) {
                    const int lo2 = 4 * half + 2 * lp;
                    float s0 = 1.f, s1 = 1.f;
                    if (oct < 24) { s0 = tabw[hh * 128 + l0 + lo2]; s1 = tabw[hh * 128 + l0 + lo2 + 1]; }
                    LAS unsigned* d = (LAS unsigned*)(dT + lo2);
                    d[0 * 68] = cvtpk(o[0][0].x * s0, o[1][0].x * s1); d[1 * 68] = cvtpk(o[0][0].y * s0, o[1][0].y * s1);
                    d[2 * 68] = cvtpk(o[0][0].z * s0, o[1][0].z * s1); d[3 * 68] = cvtpk(o[0][0].w * s0, o[1][0].w * s1);
                    d[4 * 68] = cvtpk(o[0][1].x * s0, o[1][1].x * s1); d[5 * 68] = cvtpk(o[0][1].y * s0, o[1][1].y * s1);
                    d[6 * 68] = cvtpk(o[0][1].z * s0, o[1][1].z * s1); d[7 * 68] = cvtpk(o[0][1].w * s0, o[1][1].w * s1);
                }
            }
        }
    }
    __syncthreads();
    bf16x8 bfr[4];
#pragma unroll
    for (int ks = 0; ks < 4; ++ks) bfr[ks] = *(const LAS bf16x8*)(BT + (wave * 16 + fr) * 136 + ks * 32 + fq * 8);
#pragma unroll
    for (int hh = 0; hh < 3; ++hh)
#pragma unroll
        for (int pt = 0; pt < 4; ++pt) {
            f32x4 acc = {0.f, 0.f, 0.f, 0.f};
#pragma unroll
            for (int ks = 0; ks < 4; ++ks) acc = mfma16(*(const LAS bf16x8*)(xT + (hh * 64 + pt * 16 + fr) * 136 + ks * 32 + fq * 8), bfr[ks], acc);
            float* dst = SLOC + ((((size_t)(b * NCH + c) * NH + g * 3 + hh) * 64 + pt * 16 + fq * 4) * 128) + wave * 16 + fr;
#pragma unroll
            for (int jj = 0; jj < 4; ++jj) dst[jj * 128] = acc[jj];
        }
}

__device__ __forceinline__ void ssd_sample_item(LAS unsigned char* lds, int b, const Params& P, int tid, int wave, int lane) {
    unsigned char* ws = P.ws;
    const bf16* XBC = (const bf16*)(ws + WS_XBC); const bf16* Z = (const bf16*)(ws + WS_Z); const float* DT = (const float*)(ws + WS_DT);
    bf16* mixed = (bf16*)(ws + WS_MIX);
    const float* cw = P.in[I_CW]; const float* cb = P.in[I_CB]; const float* sconv = P.in[I_SCONV]; const float* sssm = P.in[I_SSSM];
    float* out_ssm = P.out + O_SSSM;
    LAS float* xc = (LAS float*)lds;
    LAS float* dts = (LAS float*)(lds + 28672);
    LAS float* yg = (LAS float*)(lds + 28928);
    __syncthreads();
    if (tid < CONVD / 8) {
        const int col = tid * 8;
        f32x4 xin[7][2];
#pragma unroll
        for (int r = 0; r < 3; ++r) { const float* sp = sconv + ((size_t)b * 3 + r) * CONVD + col; xin[r][0] = *(const f32x4*)sp; xin[r][1] = *(const f32x4*)(sp + 4); }
#pragma unroll
        for (int r = 0; r < 4; ++r) { const u32x4 v = *(const u32x4*)(XBC + ((size_t)MP + b * 4 + r) * CONVD + col);
            xin[3 + r][0] = (f32x4){bflo(v.x), bfhi(v.x), bflo(v.y), bfhi(v.y)}; xin[3 + r][1] = (f32x4){bflo(v.z), bfhi(v.z), bflo(v.w), bfhi(v.w)}; }
        f32x4 wv[4][2];
#pragma unroll
        for (int w = 0; w < 4; ++w) { wv[w][0] = *(const f32x4*)(cw + w * CONVD + col); wv[w][1] = *(const f32x4*)(cw + w * CONVD + col + 4); }
        const f32x4 b0 = *(const f32x4*)(cb + col), b1 = *(const f32x4*)(cb + col + 4);
#pragma unroll
        for (int s = 0; s < 4; ++s) {
            f32x4 a0 = b0, a1 = b1;
#pragma unroll
            for (int w = 0; w < 4; ++w) { a0 += xin[s + w][0] * wv[w][0]; a1 += xin[s + w][1] * wv[w][1]; }
            *(LAS f32x4*)(xc + s * CONVD + col) = (f32x4){silu_f(a0.x), silu_f(a0.y), silu_f(a0.z), silu_f(a0.w)};
            *(LAS f32x4*)(xc + s * CONVD + col + 4) = (f32x4){silu_f(a1.x), silu_f(a1.y), silu_f(a1.z), silu_f(a1.w)};
        }
    }
    if (tid < 48) dts[tid] = DT[((size_t)MP + b * 4 + tid / 12) * 12 + tid % 12];
    LAS float* zs = (LAS float*)(lds + 41216);
    for (int i = tid; i < 4 * DINNER / 2; i += 512) { const unsigned zz = *(const unsigned*)(Z + ((size_t)MP + b * 4) * DINNER + 2 * i); zs[2 * i] = bflo(zz); zs[2 * i + 1] = bfhi(zz); }
    __syncthreads();
    const int p = tid >> 3, nq = tid & 7, n0 = nq * 16;
    f32x4 nx[4];
#pragma unroll
    for (int i = 0; i < 4; ++i) nx[i] = *(const f32x4*)(sssm + ((size_t)(b * NH) * 64 + p) * 128 + n0 + 4 * i);
#pragma unroll 1
    for (int h = 0; h < NH; ++h) {
        const int g = h / 3;
        const size_t so = ((size_t)(b * NH + h) * 64 + p) * 128 + n0;
        f32x4 st[4];
#pragma unroll
        for (int i = 0; i < 4; ++i) st[i] = nx[i];
        if (h + 1 < NH) {
#pragma unroll
            for (int i = 0; i < 4; ++i) nx[i] = *(const f32x4*)(sssm + so + 64 * 128 + 4 * i);
        }
        const float a = -__expf(P.in[I_ALOG][h]), Dh = P.in[I_DSKIP][h];
#pragma unroll
        for (int s = 0; s < 4; ++s) {
            const float dt = dts[s * 12 + h], dA = __expf(dt * a), xv = xc[s * CONVD + h * 64 + p], xdt = xv * dt;
            const LAS f32x4* Bv = (const LAS f32x4*)(xc + s * CONVD + DINNER + g * 128 + n0);
            const LAS f32x4* Cv = (const LAS f32x4*)(xc + s * CONVD + DINNER + 512 + g * 128 + n0);
            float y = 0.f;
#pragma unroll
            for (int i = 0; i < 4; ++i) { st[i] = st[i] * dA + Bv[i] * xdt; y += dot4(Cv[i], st[i]); }
            y += __shfl_xor(y, 1); y += __shfl_xor(y, 2); y += __shfl_xor(y, 4);
            if (nq == 0) { const float z = zs[s * DINNER + h * 64 + p]; yg[s * DINNER + h * 64 + p] = (y + Dh * xv) * silu_f(z); }
        }
#pragma unroll
        for (int i = 0; i < 4; ++i) __builtin_nontemporal_store(st[i], (f32x4*)(out_ssm + so + 4 * i));
    }
    __syncthreads();
    if (wave < 4) {
        const int s = wave; float ss = 0.f;
#pragma unroll
        for (int k = 0; k < 12; ++k) { const float v = yg[s * DINNER + lane + 64 * k]; ss += v * v; }
        const float inv = rsqrtf(wave_sum(ss) * (1.0f / DINNER) + EPS);
        const float* gs = P.in[I_NSSD];
#pragma unroll
        for (int k = 0; k < 12; ++k) { const int cc = lane + 64 * k; const float v = yg[s * DINNER + cc] * inv * gs[cc];
            mixed[((size_t)MP + b * 4 + s) * DMIX + DATT + cc] = (bf16)(cvtpk(v, 0.f) & 0xffff); }
    }
}

__device__ __forceinline__ const float* kv_row(const float* cache, const float* skv, int b, int lb, int idx) {
    return idx < lb ? cache + ((size_t)b * lb + idx) * 512 : skv + ((size_t)b * lb + (idx - 4)) * 512;
}
__device__ __forceinline__ void attn_sample_item(LAS unsigned char* lds, int item, const Params& P, int tid, int wave, int lane) {
    const int g = item % 3, b = item / 3;
    unsigned char* ws = P.ws;
    const float* QS = (const float*)(ws + WS_QS); bf16* mixed = (bf16*)(ws + WS_MIX); float* LSE = (float*)(ws + WS_LSE);
    LAS float* pl = (LAS float*)lds;
    const int sh = 2 * g, lb = 128 << sh;
    const float* cache = g == 0 ? P.in[I_C1] : (g == 1 ? P.in[I_C4] : P.in[I_C16]);
    const float* skv = P.out + (g == 0 ? O_SKV1 : (g == 1 ? O_SKV4 : O_SKV16));
    const int q4 = lane >> 4, l16 = lane & 15;
    __syncthreads();
#pragma unroll 1
    for (int k = 0; k < 2; ++k) {
        const int pi = wave * 2 + k, j = pi >> 2, s = pi & 3;
        const size_t row = (size_t)MP + b * 4 + s;
        {
            const f32x4 qv = *(const f32x4*)(QS + ((size_t)b * 4 + s) * DATT + g * 256 + j * 64 + l16 * 4) * ATT_SCALE;
#pragma unroll 1
            for (int bt = 0; bt < 3; ++bt) {
                f32x4 kv[11];
#pragma unroll
                for (int i = 0; i < 11; ++i) {
                    const int jj = (bt * 11 + i) * 4 + q4; int idx = lb + s - (jj << sh);
                    if (jj > 128 || idx < 0) idx = 0;
                    kv[i] = *(const f32x4*)(kv_row(cache, skv, b, lb, idx) + j * 64 + l16 * 4);
                }
#pragma unroll
                for (int i = 0; i < 11; ++i) {
                    const int jj = (bt * 11 + i) * 4 + q4; const int idx = lb + s - (jj << sh);
                    const bool valid = jj <= 128 && idx >= 0;
                    float d = dot4(kv[i], qv);
                    d += __shfl_xor(d, 1); d += __shfl_xor(d, 2); d += __shfl_xor(d, 4); d += __shfl_xor(d, 8);
                    pl[l16 == 0 ? wave * 132 + jj : 1056 + lane] = valid ? d : -1e30f;
                }
            }
        }
        LDS_WAIT();
        float sc[3];
#pragma unroll
        for (int u = 0; u < 3; ++u) { const int jj = lane + 64 * u; sc[u] = jj < 132 ? pl[wave * 132 + jj] : -1e30f; }
        const float mx = wave_max(fmaxf(fmaxf(sc[0], sc[1]), sc[2]));
        float den = 0.f;
#pragma unroll
        for (int u = 0; u < 3; ++u) { const int jj = lane + 64 * u; const float p = sc[u] > -1e29f ? __expf(sc[u] - mx) : 0.f; den += p; if (jj < 132) pl[wave * 132 + jj] = p; }
        den = wave_sum(den);
        LDS_WAIT();
        f32x4 o = {0.f, 0.f, 0.f, 0.f};
        {
#pragma unroll 1
            for (int bt = 0; bt < 3; ++bt) {
                f32x4 vv[11];
#pragma unroll
                for (int i = 0; i < 11; ++i) {
                    const int jj = (bt * 11 + i) * 4 + q4; int idx = lb + s - (jj << sh); if (jj > 128 || idx < 0) idx = 0;
                    vv[i] = *(const f32x4*)(kv_row(cache, skv, b, lb, idx) + 256 + j * 64 + l16 * 4);
                }
#pragma unroll
                for (int i = 0; i < 11; ++i) o += vv[i] * pl[wave * 132 + (bt * 11 + i) * 4 + q4];
            }
        }
#pragma unroll
        for (int e = 0; e < 4; ++e) { o[e] += __shfl_xor(o[e], 16); o[e] += __shfl_xor(o[e], 32); }
        o = o * (1.0f / den);
        if (q4 == 0) { u32x2 w; w.x = cvtpk(o[0], o[1]); w.y = cvtpk(o[2], o[3]); *(u32x2*)(mixed + row * DMIX + g * 256 + j * 64 + l16 * 4) = w; }
        if (lane == 0) LSE[row * 12 + g * 4 + j] = mx + __logf(den);
        LDS_WAIT();
    }
}

constexpr int NCOPY = DB * (2 + 8 + 32);
struct CopyDesc { const f32x4* src; f32x4* dst; int n4; };
__device__ __forceinline__ CopyDesc copy_desc(int ci, const Params& P) {
    int g, b, ch;
    if (ci < DB * 2) { g = 0; b = ci >> 1; ch = ci & 1; }
    else if (ci < DB * 10) { ci -= DB * 2; g = 1; b = ci >> 3; ch = ci & 7; }
    else { ci -= DB * 10; g = 2; b = ci >> 5; ch = ci & 31; }
    const int lb = 128 << (2 * g), row0 = ch * 64;
    int nrows = lb - 4 - row0; if (nrows > 64) nrows = 64;
    CopyDesc d;
    d.src = (const f32x4*)((g == 0 ? P.in[I_C1] : (g == 1 ? P.in[I_C4] : P.in[I_C16])) + ((size_t)b * lb + 4 + row0) * 512);
    d.dst = (f32x4*)(P.out + (g == 0 ? O_SKV1 : (g == 1 ? O_SKV4 : O_SKV16)) + ((size_t)b * lb + row0) * 512);
    d.n4 = nrows * 128;
    return d;
}

__device__ __forceinline__ void p2b_scan(const Params& P, int tid, int G) {
    unsigned char* ws = P.ws;
    const float* __restrict__ SLOC = (const float*)(ws + WS_SLOC); const float* __restrict__ CD = (const float*)(ws + WS_CD); bf16* __restrict__ HP = (bf16*)(ws + WS_HPREV);
    float* __restrict__ pssm = P.out + O_PSSM;
    constexpr int NV = NB * NH * 64 * 32;
    for (int v = blockIdx.x * 512 + tid; v < NV; v += G * 512) {
        const int n4 = v & 31, p = (v >> 5) & 63, bh = v >> 11, b = bh / NH, h = bh % NH;
        f32x4 run = {0.f, 0.f, 0.f, 0.f};
#pragma unroll 8
        for (int c = 0; c < NCH; ++c) {
            const size_t off = (((size_t)(b * NCH + c) * NH + h) * 64 + p) * 128 + n4 * 4;
            const f32x4 sv = *(const f32x4*)(SLOC + off); const float cd = CD[(b * NCH + c) * NH + h];
            u32x2 w; w.x = cvtpk(run.x, run.y); w.y = cvtpk(run.z, run.w);
            *(u32x2*)(HP + off) = w;
            run = run * cd + sv;
        }
        *(f32x4*)(pssm + ((size_t)(b * NH + h) * 64 + p) * 128 + n4 * 4) = run;
    }
}

__device__ __forceinline__ void alpha_rows(bf16* __restrict__ mixed, const float* __restrict__ LSE, size_t r0, int tid) {
    u32x4 v[12]; float al[12];
#pragma unroll
    for (int i = 0; i < 12; ++i) {
        const int wi = tid + 512 * i, rr = wi / 96, oc = wi % 96, c0 = oc * 8, g = c0 >> 8, j = (c0 >> 6) & 3;
        const float* lp = LSE + (r0 + rr) * 12 + j;
        const float l0 = lp[0], l1 = lp[4], l2 = lp[8];
        v[i] = *(const u32x4*)(mixed + (r0 + rr) * DMIX + c0);
        const float mx = fmaxf(l0, fmaxf(l1, l2)), e0 = __expf(l0 - mx), e1 = __expf(l1 - mx), e2 = __expf(l2 - mx);
        al[i] = (g == 0 ? e0 : (g == 1 ? e1 : e2)) / (e0 + e1 + e2);
    }
#pragma unroll
    for (int i = 0; i < 12; ++i) {
        const int wi = tid + 512 * i, rr = wi / 96, oc = wi % 96, c0 = oc * 8; const float a = al[i];
        u32x4 w; w.x = cvtpk(bflo(v[i].x) * a, bfhi(v[i].x) * a); w.y = cvtpk(bflo(v[i].y) * a, bfhi(v[i].y) * a); w.z = cvtpk(bflo(v[i].z) * a, bfhi(v[i].z) * a); w.w = cvtpk(bflo(v[i].w) * a, bfhi(v[i].w) * a);
        *(u32x4*)(mixed + (r0 + rr) * DMIX + c0) = w;
    }
}

__device__ __forceinline__ void p2c_item(LAS unsigned char* lds, int item, const Params& P, int tid, int wave, int lane, bool do_alpha = true) {
    const int hf = item & 1, c = (item >> 1) & 31, b = item >> 6;
    unsigned char* ws = P.ws;
    const bf16* xcb = (const bf16*)(ws + WS_XC) + (size_t)b * SEQ * CONVD;
    const float* DT = (const float*)(ws + WS_DT); const bf16* HP = (const bf16*)(ws + WS_HPREV); const bf16* Z = (const bf16*)(ws + WS_Z);
    bf16* mixed = (bf16*)(ws + WS_MIX); const float* LSE = (const float*)(ws + WS_LSE);
    LAS bf16* Bn = (LAS bf16*)lds;
    LAS bf16* Cn = (LAS bf16*)(lds + 34816);
    LAS bf16* xT = (LAS bf16*)(lds + 52224);
    LAS float* tdt = (LAS float*)(lds + 104448);
    LAS float* tac = (LAS float*)(lds + 105984);
    LAS float* ssl = (LAS float*)(lds + 107520);
    const int fr = lane & 15, fq = lane >> 4, rt = wave & 3, ph = wave >> 2;
    const int smax = 64 * (hf + 1), lg = 64 * hf + 16 * rt + fr;
    const size_t row = (size_t)b * SEQ + c * 128 + lg;
    const int npairs = ((hf * 4 + rt) >> 1) + 1;
    float ssq = 0.f;
    for (int g = 0; g < 4; ++g) {
        __syncthreads();
        if (wave < 3) {
            const int h = g * 3 + wave; const float a = -__expf(P.in[I_ALOG][h]);
            const size_t r0 = (size_t)b * SEQ + c * 128 + 2 * lane;
            const float d0 = DT[r0 * 12 + h], d1 = DT[(r0 + 1) * 12 + h];
            float i0, i1, tot; scan128(d0 * a, d1 * a, lane, i0, i1, tot);
            tdt[wave * 128 + 2 * lane] = d0; tdt[wave * 128 + 2 * lane + 1] = d1;
            tac[wave * 128 + 2 * lane] = i0; tac[wave * 128 + 2 * lane + 1] = i1;
        }
        if (tid >= 192) {
            u32x4 sv[10];
#pragma unroll
            for (int i = 0; i < 10; ++i) {
                const int wi = tid - 192 + 320 * i; sv[i] = (u32x4){0u, 0u, 0u, 0u};
                if (wi < smax * 16) { const int oct = wi & 15, s = wi >> 4; sv[i] = *(const u32x4*)(xcb + (size_t)(c * 128 + s) * CONVD + DINNER + g * 128 + oct * 8); }
                else if (wi < smax * 16 + 1024) { const int w2 = wi - smax * 16, oct = w2 & 15, l = w2 >> 4; sv[i] = *(const u32x4*)(xcb + (size_t)(c * 128 + 64 * hf + l) * CONVD + DINNER + 512 + g * 128 + oct * 8); }
            }
#pragma unroll
            for (int i = 0; i < 10; ++i) {
                const int wi = tid - 192 + 320 * i;
                if (wi < smax * 16) { const int oct = wi & 15, s = wi >> 4; *(LAS u32x4*)(Bn + s * 136 + oct * 8) = sv[i]; }
                else if (wi < smax * 16 + 1024) { const int w2 = wi - smax * 16, oct = w2 & 15, l = w2 >> 4; *(LAS u32x4*)(Cn + l * 136 + oct * 8) = sv[i]; }
            }
        } else if (tid < 24 * (smax >> 4)) {
            const int oct = tid % 24, seg = tid / 24, s0 = seg * 16, hh = oct >> 3;
            u32x4 r[16];
#pragma unroll
            for (int i = 0; i < 16; ++i) r[i] = *(const u32x4*)(xcb + (size_t)(c * 128 + s0 + i) * CONVD + g * 192 + oct * 8);
            LAS unsigned* d = (LAS unsigned*)(xT + (hh * 64 + (oct & 7) * 8) * 136 + s0);
#pragma unroll
            for (int i = 0; i < 8; ++i) {
                const u32x4 a0 = r[2 * i], a1 = r[2 * i + 1];
                d[0 * 68 + i] = (a0.x & 0xffffu) | (a1.x << 16); d[1 * 68 + i] = (a0.x >> 16) | (a1.x & 0xffff0000u);
                d[2 * 68 + i] = (a0.y & 0xffffu) | (a1.y << 16); d[3 * 68 + i] = (a0.y >> 16) | (a1.y & 0xffff0000u);
                d[4 * 68 + i] = (a0.z & 0xffffu) | (a1.z << 16); d[5 * 68 + i] = (a0.z >> 16) | (a1.z & 0xffff0000u);
                d[6 * 68 + i] = (a0.w & 0xffffu) | (a1.w << 16); d[7 * 68 + i] = (a0.w >> 16) | (a1.w & 0xffff0000u);
            }
        }
        __syncthreads();
        bf16x8 cfr[4];
#pragma unroll
        for (int ks = 0; ks < 4; ++ks) cfr[ks] = *(const LAS bf16x8*)(Cn + (16 * rt + fr) * 136 + ks * 32 + fq * 8);
        f32x4 accY[3][2];
#pragma unroll
        for (int h = 0; h < 3; ++h) { accY[h][0] = (f32x4){0.f, 0.f, 0.f, 0.f}; accY[h][1] = (f32x4){0.f, 0.f, 0.f, 0.f}; }
        float acl[3];
#pragma unroll
        for (int h = 0; h < 3; ++h) acl[h] = tac[h * 128 + lg];
        const bf16* hpb = HP + ((((size_t)(b * NCH + c) * NH + g * 3) * 64 + 2 * ph * 16 + fr) * 128) + fq * 8;
        bf16x8 hpc[2][4];
#pragma unroll
        for (int pti = 0; pti < 2; ++pti)
#pragma unroll
            for (int ks = 0; ks < 4; ++ks) hpc[pti][ks] = *(const bf16x8*)(hpb + pti * 16 * 128 + ks * 32);
        for (int sp = 0; sp < npairs; ++sp) {
            f32x4 cbv[2];
#pragma unroll
            for (int u = 0; u < 2; ++u) {
                f32x4 a = {0.f, 0.f, 0.f, 0.f};
#pragma unroll
                for (int ks = 0; ks < 4; ++ks) a = mfma16(*(const LAS bf16x8*)(Bn + ((2 * sp + u) * 16 + fr) * 136 + ks * 32 + fq * 8), cfr[ks], a);
                cbv[u] = a;
            }
#pragma unroll
            for (int h = 0; h < 3; ++h) {
                float mv[8];
#pragma unroll
                for (int u = 0; u < 2; ++u) {
                    const int s0 = (2 * sp + u) * 16 + fq * 4;
                    const f32x4 as = *(const LAS f32x4*)(tac + h * 128 + s0), ds = *(const LAS f32x4*)(tdt + h * 128 + s0);
#pragma unroll
                    for (int jj = 0; jj < 4; ++jj) {
                        const float e = fminf(acl[h] - as[jj], 0.f);
                        mv[u * 4 + jj] = (s0 + jj <= lg) ? cbv[u][jj] * __expf(e) * ds[jj] : 0.f;
                    }
                }
                const bf16x8 pf = mk8(cvtpk(mv[0], mv[1]), cvtpk(mv[2], mv[3]), cvtpk(mv[4], mv[5]), cvtpk(mv[6], mv[7]));
#pragma unroll
                for (int pti = 0; pti < 2; ++pti) {
                    const LAS bf16* xr = xT + (h * 64 + (2 * ph + pti) * 16 + fr) * 136 + (2 * sp) * 16 + fq * 4;
                    const u32x2 lo = *(const LAS u32x2*)xr, hi = *(const LAS u32x2*)(xr + 16);
                    accY[h][pti] = mfma16(mk8(lo.x, lo.y, hi.x, hi.y), pf, accY[h][pti]);
                }
            }
        }
#pragma unroll
        for (int h = 0; h < 3; ++h) {
            const int hd = g * 3 + h; const float Dh = P.in[I_DSKIP][hd], eal = __expf(acl[h]);
            bf16x8 hpn[2][4];
            if (h < 2) {
#pragma unroll
                for (int pti = 0; pti < 2; ++pti)
#pragma unroll
                    for (int ks = 0; ks < 4; ++ks) hpn[pti][ks] = *(const bf16x8*)(hpb + (size_t)(h + 1) * 64 * 128 + pti * 16 * 128 + ks * 32);
            }
#pragma unroll
            for (int pti = 0; pti < 2; ++pti) {
                const int pt = 2 * ph + pti;
                f32x4 a = {0.f, 0.f, 0.f, 0.f};
#pragma unroll
                for (int ks = 0; ks < 4; ++ks) a = mfma16(hpc[pti][ks], cfr[ks], a);
                const f32x4 y = accY[h][pti] + a * eal;
                const int pc = hd * 64 + pt * 16 + fq * 4;
                const u32x2 zr = *(const u32x2*)(Z + row * DINNER + pc);
                const float z0 = bflo(zr.x), z1 = bfhi(zr.x), z2 = bflo(zr.y), z3 = bfhi(zr.y);
                const LAS bf16* xc = xT + (h * 64 + pt * 16 + fq * 4) * 136 + lg;
                const float y0 = (y[0] + Dh * bf2f(xc[0])) * silu_f(z0), y1 = (y[1] + Dh * bf2f(xc[136])) * silu_f(z1);
                const float y2 = (y[2] + Dh * bf2f(xc[2 * 136])) * silu_f(z2), y3 = (y[3] + Dh * bf2f(xc[3 * 136])) * silu_f(z3);
                ssq += (y0 * y0 + y1 * y1) + (y2 * y2 + y3 * y3);
                u32x2 w; w.x = cvtpk(y0, y1); w.y = cvtpk(y2, y3);
                *(u32x2*)(mixed + row * DMIX + DATT + pc) = w;
            }
            if (h < 2) {
#pragma unroll
                for (int pti = 0; pti < 2; ++pti)
#pragma unroll
                    for (int ks = 0; ks < 4; ++ks) hpc[pti][ks] = hpn[pti][ks];
            }
        }
    }
    ssq += __shfl_xor(ssq, 16); ssq += __shfl_xor(ssq, 32);
    if (fq == 0) ssl[ph * 64 + 16 * rt + fr] = ssq;
    __syncthreads();
    {
        const float tot = ssl[16 * rt + fr] + ssl[64 + 16 * rt + fr];
        const float inv = rsqrtf(tot * (1.0f / DINNER) + EPS);
        const float* __restrict__ gs = P.in[I_NSSD];
#pragma unroll
        for (int hh = 0; hh < 2; ++hh) {
            u32x2 rv[6][2]; f32x4 gv[6][2];
#pragma unroll
            for (int k = 0; k < 6; ++k)
#pragma unroll
                for (int pti = 0; pti < 2; ++pti) {
                    const int pc = (hh * 6 + k) * 64 + (2 * ph + pti) * 16 + fq * 4;
                    rv[k][pti] = *(const u32x2*)(mixed + row * DMIX + DATT + pc); gv[k][pti] = *(const f32x4*)(gs + pc);
                }
#pragma unroll
            for (int k = 0; k < 6; ++k)
#pragma unroll
                for (int pti = 0; pti < 2; ++pti) {
                    const int pc = (hh * 6 + k) * 64 + (2 * ph + pti) * 16 + fq * 4;
                    const u32x2 v = rv[k][pti]; const f32x4 g4 = gv[k][pti];
                    u32x2 w; w.x = cvtpk(bflo(v.x) * inv * g4.x, bfhi(v.x) * inv * g4.y); w.y = cvtpk(bflo(v.y) * inv * g4.z, bfhi(v.y) * inv * g4.w);
                    *(u32x2*)(mixed + row * DMIX + DATT + pc) = w;
                }
        }
    }
    if (do_alpha) alpha_rows(mixed, LSE, (size_t)b * SEQ + c * 128 + 64 * hf, tid);
}

__device__ __forceinline__ void p6_final(const Params& P, int wave, int lane, int G) {
    const float* SS2 = (const float*)(P.ws + WS_SS2); const float* gf = P.in[I_NFIN];
    const int gw = blockIdx.x * 8 + wave, NGW = G * 8;
    f32x4 gv[4];
#pragma unroll
    for (int j = 0; j < 4; ++j) gv[j] = ((const f32x4*)gf)[lane + 64 * j];
    f32x4 nv[4]; float ns = 0.f;
    if (gw < M) { ns = SS2[gw];
#pragma unroll
        for (int j = 0; j < 4; ++j) nv[j] = ((const f32x4*)(P.out + (size_t)gw * DM))[lane + 64 * j]; }
#pragma unroll 1
    for (int row = gw; row < M; row += NGW) {
        f32x4 v[4]; const float s2 = ns;
#pragma unroll
        for (int j = 0; j < 4; ++j) v[j] = nv[j];
        const int nr = row + NGW;
        if (nr < M) { ns = SS2[nr];
#pragma unroll
            for (int j = 0; j < 4; ++j) nv[j] = ((const f32x4*)(P.out + (size_t)nr * DM))[lane + 64 * j]; }
        const float inv = rsqrtf(s2 * (1.0f / DM) + EPS);
        f32x4* yr = (f32x4*)(P.out + (size_t)row * DM);
#pragma unroll
        for (int j = 0; j < 4; ++j) yr[lane + 64 * j] = v[j] * inv * gv[j];
    }
}

#define XB_TMO      128
#define XB_XCNT(j)  (256  + 64 * (j))
#define XB_XSUB(j)  (1280 + 64 * (j))
#define XB_XGEN(j)  (2304 + 64 * (j))
#define XB_TOP      3328
#define XB_TOPGEN   3392
#define XCD_BAR_WORDS 3456
#define XB_SPIN_CAP (1u << 18)

__device__ __forceinline__ unsigned xb_ld(unsigned* p)              { return __hip_atomic_load(p, __ATOMIC_RELAXED, __HIP_MEMORY_SCOPE_AGENT); }
__device__ __forceinline__ unsigned xb_add(unsigned* p, unsigned v) { return __hip_atomic_fetch_add(p, v, __ATOMIC_RELAXED, __HIP_MEMORY_SCOPE_AGENT); }
__device__ __forceinline__ unsigned xb_xcc_id() { return (unsigned)__builtin_amdgcn_s_getreg((3 << 11) | 20) & 0xFu; }
#define XB_SPIN(cond, bar) do { unsigned _sp = 0; while (cond) { __builtin_amdgcn_s_sleep(1); \
    if ((++_sp & 255u) == 0u) { if (xb_ld(&(bar)[XB_TMO])) break; if (_sp > XB_SPIN_CAP) { atomicAdd(&(bar)[XB_TMO], 1u); break; } } } } while (0)

struct XcdBarrier {
    unsigned* bar; unsigned x;
    volatile LAS unsigned* st;
};

__device__ __forceinline__ XcdBarrier xcd_barrier_post(unsigned* bar, volatile LAS unsigned* st) {
    XcdBarrier b; b.bar = bar; b.x = xb_xcc_id(); b.st = st;
    if (threadIdx.x == 0) (void)xb_add(&bar[XB_XCNT(b.x)], 1u);
    return b;
}
__device__ __forceinline__ void xcd_barrier_complete(unsigned* bar, unsigned x, unsigned& nloc, unsigned& nx) {
    const unsigned G = gridDim.x * gridDim.y * gridDim.z;
    unsigned sum, cnt, mine, sp = 0u;
    for (;;) {
        sum = 0u; cnt = 0u; mine = 0u;
#pragma unroll
        for (unsigned j = 0; j < 16; ++j) { const unsigned c = xb_ld(&bar[XB_XCNT(j)]); sum += c; cnt += (c > 0u) ? 1u : 0u; mine = (j == x) ? c : mine; }
        if (sum == G) break;
        __builtin_amdgcn_s_sleep(1);
        if ((++sp & 255u) == 0u) { if (xb_ld(&bar[XB_TMO])) break; if (sp > XB_SPIN_CAP) { atomicAdd(&bar[XB_TMO], 1u); break; } }
    }
    nloc = mine > 0u ? mine : 1u; nx = cnt > 0u ? cnt : 1u;
}

__device__ __forceinline__ void xcd_barrier(const XcdBarrier& b) {
    asm volatile("s_waitcnt vmcnt(0)" ::: "memory");
    __syncthreads();
    if (threadIdx.x == 0) {
        unsigned* bar = b.bar;
        __builtin_amdgcn_s_waitcnt(0);
        unsigned nloc = b.st[0], nx = b.st[1];
        if (nloc == 0u) { xcd_barrier_complete(bar, b.x, nloc, nx); b.st[0] = nloc; b.st[1] = nx; }
        const unsigned old = xb_add(&bar[XB_XSUB(b.x)], 1u);
        const unsigned gen = old / nloc;
        if (old + 1u == (gen + 1u) * nloc) {
            __builtin_amdgcn_fence(__ATOMIC_RELEASE, "agent");
            asm volatile("s_waitcnt vmcnt(0)" ::: "memory");
            const unsigned og = xb_add(&bar[XB_TOP], 1u);
            const unsigned tg = og / nx;
            if (og + 1u == (tg + 1u) * nx) xb_add(&bar[XB_TOPGEN], 1u);
            else XB_SPIN(xb_ld(&bar[XB_TOPGEN]) == tg, bar);
            __builtin_amdgcn_fence(__ATOMIC_ACQUIRE, "agent");
            xb_add(&bar[XB_XGEN(b.x)], 1u);
            asm volatile("s_waitcnt vmcnt(0)" ::: "memory");
        } else {
            XB_SPIN(xb_ld(&bar[XB_XGEN(b.x)]) == gen, bar);
            __builtin_amdgcn_fence(__ATOMIC_ACQUIRE, "agent");
            asm volatile("s_waitcnt vmcnt(0)" ::: "memory");
        }
    }
    __syncthreads();
}

#ifndef MK_ONE_LAUNCH
#define MK_ONE_LAUNCH 1
#endif
constexpr int GG = 132;
#ifndef NC_ACT
#define NC_ACT 124
#endif
__device__ __forceinline__ void filler(const Params& P, LAS unsigned char* lds, int tid, int ph, bool drain) {
    unsigned* ctl = (unsigned*)(P.ws + WS_CTL);
    unsigned* head = ctl + 4160; unsigned* done = ctl + 4224 + 64 * ph;
    LAS int* wq = (LAS int*)(lds + BAR_LDS_OFF + 64);
    __syncthreads();
    const bool gemm_wg = (int)blockIdx.x < GG;
    if (tid == 0 && gemm_wg) __hip_atomic_fetch_add(done, 1u, __ATOMIC_RELAXED, __HIP_MEMORY_SCOPE_AGENT);
    if (gemm_wg && !drain) return;
    unsigned nxt = (unsigned)NCOPY, dn = 0u;
    if (tid == 0) nxt = __hip_atomic_fetch_add(head, 1u, __ATOMIC_RELAXED, __HIP_MEMORY_SCOPE_AGENT);
    for (;;) {
        if (tid == 0) wq[0] = nxt < (unsigned)NCOPY ? (int)nxt : -1;
        __syncthreads();
        const int ci = wq[0];
        __syncthreads();
        if (ci < 0) break;
        if (tid == 0) {
            if (drain || dn < (unsigned)GG) { nxt = __hip_atomic_fetch_add(head, 1u, __ATOMIC_RELAXED, __HIP_MEMORY_SCOPE_AGENT); dn = __hip_atomic_load(done, __ATOMIC_RELAXED, __HIP_MEMORY_SCOPE_AGENT); }
            else nxt = (unsigned)NCOPY;
        }
        const CopyDesc d = copy_desc(ci, P);
        f32x4 v[16];
#pragma unroll
        for (int i = 0; i < 16; ++i) { const int idx = tid + 512 * i; if (idx < d.n4) v[i] = __builtin_nontemporal_load(d.src + idx); }
#pragma unroll
        for (int i = 0; i < 16; ++i) { const int idx = tid + 512 * i; if (idx < d.n4) __builtin_nontemporal_store(v[i], d.dst + idx); }
    }
}
#ifndef GREP
#define GREP 1
#endif
struct RepOrder {
    pg8::StaticOrder b; int nc;
    __device__ __forceinline__ void init(int M_, int N_, int G_, int c_) { b.init(M_, N_, G_, c_); nc = c_ < b.nwg ? (b.nwg - c_ + G_ - 1) / G_ : 0; }
    __device__ __forceinline__ bool next(int i, pg8::Unit& u) const { if (i >= nc * GREP) return false; return b.next(i % nc, u); }
    __device__ __forceinline__ void a_ready(const pg8::Unit&) const {}
    __device__ __forceinline__ void done(const pg8::Unit&) const {}
};
constexpr int N_PHASES = 9;
#ifndef FILL_MASK
#define FILL_MASK 0xA0
#endif
constexpr int NCOPY3 = 1900;
struct Args { Params P; int ph_lo, ph_hi; };
static_assert(sizeof(Args) == 22 * 8 + 8, "no padding in Args");

__global__ void __launch_bounds__(512, 2) hybrid_fwd(Args args) {
    extern __shared__ __attribute__((aligned(16))) unsigned char lds_raw[];
    LAS unsigned char* lds = (LAS unsigned char*)lds_raw;
    const Params& P = args.P;
    const int tid = threadIdx.x, lane = tid & 63, wave = __builtin_amdgcn_readfirstlane(tid >> 6), G = gridDim.x;
    unsigned char* ws = P.ws;
    const int lo = args.ph_lo, hi = args.ph_hi;
    if (lo > 1000) cg::this_grid().sync();
    if (tid < 2) ((LAS unsigned*)(lds + BAR_LDS_OFF))[tid] = 0u;
    __syncthreads();
    (void)xcd_barrier_post((unsigned*)(ws + WS_CTL), (volatile LAS unsigned*)(lds + BAR_LDS_OFF));
#define IN(k) (lo <= (k) && (k) < hi)
#define FILL(k) do { if ((FILL_MASK >> (k)) & 1) filler(P, lds, tid, (k), (k) == 7); } while (0)
#define SEAM(k) do { if (IN(k) && IN((k) + 1)) { XcdBarrier bb; bb.bar = (unsigned*)(args.P.ws + WS_CTL); bb.x = xb_xcc_id(); bb.st = (volatile LAS unsigned*)(lds + BAR_LDS_OFF); xcd_barrier(bb); } } while (0)
    if (IN(0)) { p0_prologue(P, lds, tid, wave, lane, G); }
    SEAM(0);
    if (IN(1)) {
        pg8::Gemm g{(const pg8::bf16_t*)(ws + WS_XN), (const pg8::bf16_t*)(ws + WS_WIN), M, NIN, DM}; RepOrder S; S.init(M, NIN, G, (int)blockIdx.x);
        EpiIn E{(bf16*)(ws + WS_Q), (bf16*)(ws + WS_K), (bf16*)(ws + WS_V), (bf16*)(ws + WS_Z), (bf16*)(ws + WS_XBC), (float*)(ws + WS_QS), P.out};
        pg8::gemm_phase<EpiIn, RepOrder, true, true>(lds, g, S, E);
        FILL(1);
    }
    SEAM(1);
    if (IN(2)) {
        constexpr int NSA = 384, NATT = 1536, NPA = 512, NSS = 128, NCOMP = NSA + NATT + NPA + NSS;
        unsigned* ctr = (unsigned*)(ws + WS_CTL) + 4096;
        LAS int* wq = (LAS int*)(lds + BAR_LDS_OFF + 64);
        unsigned nxt = 0u;
        if (tid == 0) nxt = atomicAdd(ctr, 1u);
        for (;;) {
            __syncthreads();
            if (tid == 0) *wq = (int)nxt;
            __syncthreads();
            int r = *wq;
            if (r >= NCOMP) break;
            if (tid == 0) nxt = atomicAdd(ctr, 1u);
            int t_ = tid; asm volatile("" : "+v"(t_));
            const int l_ = t_ & 63, w_ = __builtin_amdgcn_readfirstlane(t_ >> 6);
            if (r < NSS) { ssd_sample_item(lds, r, P, t_, w_, l_); continue; } r -= NSS;
            if (r < NSA) { attn_sample_item(lds, r, P, t_, w_, l_); continue; } r -= NSA;
            if (r < NPA) { ssd_passA_item(lds, r, P, t_, w_, l_); continue; } r -= NPA;
            attn_item(lds, r, (const bf16*)(ws + WS_Q), (const bf16*)(ws + WS_K), (const bf16*)(ws + WS_V), (bf16*)(ws + WS_MIX), (float*)(ws + WS_LSE), t_, w_, l_);
        }
        FILL(2);
    }
    SEAM(2);
    if (IN(3)) { p2b_scan(P, tid, G); }
    SEAM(3);
    if (IN(4)) {
        for (int it = blockIdx.x; it < NB * NCH * 2 + MS / 64; it += G) {
            if (it < NB * NCH * 2) p2c_item(lds, it, P, tid, wave, lane);
            else alpha_rows((bf16*)(ws + WS_MIX), (const float*)(ws + WS_LSE), (size_t)MP + (it - NB * NCH * 2) * 64, tid);
        }
        FILL(4);
    }
    SEAM(4);
    if (IN(5)) {
        if ((int)blockIdx.x < GG) {
            pg8::Gemm g{(const pg8::bf16_t*)(ws + WS_MIX), (const pg8::bf16_t*)(ws + WS_WO), M, DM, DMIX}; pg8::StaticOrder S; S.init(M, DM, GG, (int)blockIdx.x);
            EpiOut E{P.in[I_XP], P.in[I_XS], P.in[I_NFFN], (float*)(ws + WS_H), (bf16*)(ws + WS_XN), (float*)(ws + WS_SS1)};
            pg8::gemm_phase<EpiOut, pg8::StaticOrder, true, true>(lds, g, S, E);
        }
        FILL(5);
    }
    SEAM(5);
    if (IN(6)) {
        pg8::Gemm g{(const pg8::bf16_t*)(ws + WS_XN), (const pg8::bf16_t*)(ws + WS_WGU), M, NGU, DM}; RepOrder S; S.init(M, NGU, G, (int)blockIdx.x);
        EpiGU E{(const float*)(ws + WS_SS1), (bf16*)(ws + WS_ACT)};
        pg8::gemm_phase<EpiGU, RepOrder, true, true>(lds, g, S, E);
        FILL(6);
    }
    SEAM(6);
    if (IN(7)) {
        if ((int)blockIdx.x < GG) {
            pg8::Gemm g{(const pg8::bf16_t*)(ws + WS_ACT), (const pg8::bf16_t*)(ws + WS_WD), M, DM, DFF}; pg8::StaticOrder S; S.init(M, DM, GG, (int)blockIdx.x);
            EpiDown E{(const float*)(ws + WS_H), P.out, (float*)(ws + WS_SS2)};
            pg8::gemm_phase<EpiDown, pg8::StaticOrder, true, true>(lds, g, S, E);
        }
        FILL(7);
    }
    SEAM(7);
    if (IN(8)) { p6_final(P, wave, lane, G); }
#undef IN
#undef FILL
#undef SEAM
}

extern "C" void kernel_launch(void* const* d_in, const int* in_sizes, int n_in, void* d_out, int out_size, void* d_ws, size_t ws_size, hipStream_t stream) {
    static int grid = 0;
    if (grid == 0) {
        if (n_in != 20 || (size_t)out_size != O_END || ws_size < WS_END) { fprintf(stderr, "kernel_launch: unexpected shapes: n_in %d out %d ws %zu (need %zu)\n", n_in, out_size, ws_size, (size_t)WS_END); grid = -1; return; }
        int dev = 0, cus = 0, per_cu = 0;
        (void)hipGetDevice(&dev); (void)hipDeviceGetAttribute(&cus, hipDeviceAttributeMultiprocessorCount, dev);
        if (hipFuncSetAttribute((const void*)hybrid_fwd, hipFuncAttributeMaxDynamicSharedMemorySize, LDS_BYTES) != hipSuccess) { fprintf(stderr, "kernel_launch: hipFuncSetAttribute failed\n"); grid = -1; return; }
        if (hipOccupancyMaxActiveBlocksPerMultiprocessor(&per_cu, (const void*)hybrid_fwd, 512, LDS_BYTES) != hipSuccess || per_cu < 1) { fprintf(stderr, "kernel_launch: occupancy query says %d\n", per_cu); per_cu = 1; }
        (void)hipGetLastError();
        grid = cus > 0 ? cus : 256;
    }
    if (grid < 0) return;
    (void)hipMemsetAsync((char*)d_ws + WS_CTL, 0, CTL_BYTES, stream);
    Args a{};
    for (int i = 0; i < 20; ++i) a.P.in[i] = (const float*)d_in[i];
    a.P.out = (float*)d_out; a.P.ws = (unsigned char*)d_ws;
#if MK_ONE_LAUNCH
    a.ph_lo = 0; a.ph_hi = N_PHASES;
    void* kargs[] = {&a};
    hipError_t e = hipLaunchCooperativeKernel((const void*)hybrid_fwd, dim3(grid), dim3(512), kargs, LDS_BYTES, stream);
    if (e != hipSuccess) fprintf(stderr, "kernel_launch: cooperative launch failed: %s (grid %d)\n", hipGetErrorString(e), grid);
#else
    for (int ph = 0; ph < N_PHASES; ++ph) {
        a.ph_lo = ph; a.ph_hi = ph + 1;
        hipLaunchKernelGGL(hybrid_fwd, dim3(grid), dim3(512), LDS_BYTES, stream, a);
    }
#endif
}
```

```cpp
#include <hip/hip_runtime.h>
#include <hip/hip_cooperative_groups.h>
#include <cstdio>
#include <cstdint>
namespace cg = cooperative_groups;
namespace pg8 {
#define PG8_LAS __attribute__((address_space(3)))
typedef unsigned short bf16_t;
typedef short bf16x8 __attribute__((ext_vector_type(8)));
typedef float f32x4 __attribute__((ext_vector_type(4)));
typedef unsigned u32x4 __attribute__((ext_vector_type(4)));
constexpr int BM = 256, BK = 64, HALF = 128, HTB = HALF * BK * 2  , STAGE_BYTES = 8 * HTB, NXCD = 8, WGM = 8;

__host__ __device__ __forceinline__ int lds_byte(int r, int c) { const int st = (r >> 4) * 2 + (c >> 5), rr = r & 15, cc = c & 31, ob = rr * 64 + cc * 2; return st * 1024 + (ob ^ (((ob >> 9) & 1) << 5)); }
__host__ __device__ __forceinline__ void stage_rc(int b, int& R, int& C) { const int st = b / 1024, sb = b % 1024, swz = sb ^ (((sb >> 9) & 1) << 5); R = (st >> 1) * 16 + swz / 64; C = (st & 1) * 32 + (swz % 64) / 2; }
__host__ __device__ __forceinline__ int perm32(int rho) { const int n = rho >> 4, i = rho & 15; return 8 * (i >> 2) + 4 * n + (i & 3); }

struct Unit { int pm, pn; };
struct Gemm { const bf16_t* A; const bf16_t* Bt; int M, N, K; };

struct StaticOrder {
    int nM, nN, nwg, G, c;
    __host__ __device__ __forceinline__ void init(int M, int N, int G_, int c_) { nM = M / BM; nN = N / BM; nwg = nM * nN; G = G_; c = c_; }
    __host__ __device__ __forceinline__ bool next(int i, Unit& u) const {
        const long L = (long)i * G + c; if (L >= nwg) return false;
        int wgid = (int)L; { const int q = nwg / NXCD, r = nwg % NXCD, xcd = wgid % NXCD, off = wgid / NXCD; wgid = (xcd < r ? xcd * (q + 1) : r * (q + 1) + (xcd - r) * q) + off; }
        const int nig = WGM * nN, gid = wgid / nig, fm = gid * WGM, gsz = (nM - fm) < WGM ? (nM - fm) : WGM;
        u.pm = fm + ((wgid % nig) % gsz); u.pn = (wgid % nig) / gsz; return true;
    }
    __device__ __forceinline__ void a_ready(const Unit&) const {}
    __device__ __forceinline__ void done(const Unit&) const {}
};

__device__ __forceinline__ unsigned cvt_pk_bf16(float lo, float hi) { unsigned r; asm volatile("v_cvt_pk_bf16_f32 %0, %1, %2" : "=v"(r) : "v"(lo), "v"(hi)); return r; }
template <class Epi, class Sched, bool ALIGN_EPI = false, bool SP2 = false>
__device__ __forceinline__ void gemm_phase(PG8_LAS unsigned char* lds, const Gemm g, const Sched& S, const Epi& E) {
    int tid_ = threadIdx.x; asm volatile("" : "+v"(tid_));
    const int tid = tid_, wid = __builtin_amdgcn_readfirstlane(tid >> 6), lane = tid & 63, wr = wid >> 2, wc = wid & 3, fr = lane & 15, fq = lane >> 4;
    const int K = g.K, nt = K / BK;
    unsigned voffA[2], voffB[2];
#pragma unroll
    for (int i = 0; i < 2; ++i) { int R, C; stage_rc(tid * 16 + i * 8192, R, C); const int Rb = Epi::PERM ? ((R & ~31) + perm32(R & 31)) : R;
        voffA[i] = (unsigned)(R * K + C) * 2u; voffB[i] = (unsigned)(Rb * K + C) * 2u; }
    const size_t kstep = (size_t)(BK * 2);
    const size_t hstep = (size_t)HALF * K * 2;
    const size_t tstep = 2 * hstep;
    const unsigned ldsw = (unsigned)wid * 1024u;
    const int aoff = lds_byte(wr * 64 + fr, fq * 8), boff = lds_byte(wc * 32 + fr, fq * 8);
#define PG8_SA(b, h) (((b) * 2 + (h)) * HTB)
#define PG8_SB(b, h) ((4 + (b) * 2 + (h)) * HTB)
#define PG8_STAGE(bufoff, gbase, voff) do { _Pragma("unroll") for (int _i = 0; _i < 2; ++_i) \
        __builtin_amdgcn_global_load_lds((const unsigned*)((const char*)(gbase) + (voff)[_i]), (PG8_LAS unsigned*)(lds + (bufoff) + ldsw + _i * 8192), 16, 0, 0); } while (0)
#define PG8_LDA(dst, b, h) do { _Pragma("unroll") for (int m = 0; m < 4; ++m) _Pragma("unroll") for (int k = 0; k < 2; ++k) dst[m][k] = *(const PG8_LAS bf16x8*)(lds + PG8_SA(b, h) + aoff + m * 2048 + k * 1024); } while (0)
#define PG8_LDB(dst, b, h) do { _Pragma("unroll") for (int n = 0; n < 2; ++n) _Pragma("unroll") for (int k = 0; k < 2; ++k) dst[n][k] = *(const PG8_LAS bf16x8*)(lds + PG8_SB(b, h) + boff + n * 2048 + k * 1024); } while (0)
#define PG8_MMA(ai, bj, At, Bt) do { __builtin_amdgcn_s_setprio(1); _Pragma("unroll") for (int m = 0; m < 4; ++m) _Pragma("unroll") for (int n = 0; n < 2; ++n) _Pragma("unroll") for (int k = 0; k < 2; ++k) \
        acc[ai][bj][m][n] = __builtin_amdgcn_mfma_f32_16x16x32_bf16(Bt[n][k], At[m][k], acc[ai][bj][m][n], 0, 0, 0); __builtin_amdgcn_s_setprio(0); } while (0)
#define PG8_WAIT_V(n) asm volatile("s_waitcnt vmcnt(" #n ")" ::: "memory")
#define PG8_WAIT_L(n) asm volatile("s_waitcnt lgkmcnt(" #n ")" ::: "memory")
#define PG8_BAR __builtin_amdgcn_s_barrier()
#define PG8_SCHED __builtin_amdgcn_sched_barrier(0)
    Unit cur, nxt; int ui = 0;
    if (!S.next(0, cur)) return;
    f32x4 acc[2][2][4][2];
#pragma unroll
    for (int a = 0; a < 2; ++a)
#pragma unroll
        for (int b = 0; b < 2; ++b)
#pragma unroll
            for (int m = 0; m < 4; ++m)
#pragma unroll
                for (int n = 0; n < 2; ++n) acc[a][b][m][n] = (f32x4){0.f, 0.f, 0.f, 0.f};
    bf16x8 At[4][2], B0[2][2], B1[2][2];
    const char* cA = (const char*)g.A + (size_t)cur.pm * tstep; const char* cB = (const char*)g.Bt + (size_t)cur.pn * tstep;
    S.a_ready(cur);
    if constexpr (SP2) {
        PG8_STAGE(PG8_SB(0, 0), cB, voffB); PG8_STAGE(PG8_SB(0, 1), cB + hstep, voffB); PG8_STAGE(PG8_SA(0, 0), cA, voffA); PG8_STAGE(PG8_SA(0, 1), cA + hstep, voffA);
        if (wr == 1) PG8_BAR;
        PG8_WAIT_V(2); PG8_BAR;
        PG8_STAGE(PG8_SB(1, 0), cB + kstep, voffB); PG8_STAGE(PG8_SA(1, 0), cA + kstep, voffA); PG8_STAGE(PG8_SB(1, 1), cB + hstep + kstep, voffB);
        PG8_WAIT_V(6); PG8_BAR;
    } else {
        PG8_STAGE(PG8_SB(0, 0), cB, voffB); PG8_STAGE(PG8_SA(0, 0), cA, voffA); PG8_STAGE(PG8_SB(0, 1), cB + hstep, voffB); PG8_STAGE(PG8_SA(0, 1), cA + hstep, voffA);
        if (wr == 1) PG8_BAR;
        PG8_WAIT_V(4); PG8_BAR;
        PG8_STAGE(PG8_SB(1, 0), cB + kstep, voffB); PG8_STAGE(PG8_SA(1, 0), cA + kstep, voffA); PG8_STAGE(PG8_SB(1, 1), cB + hstep + kstep, voffB);
        PG8_WAIT_V(6); PG8_BAR;
    }
    for (;;) {
        const bool has_next = S.next(ui + 1, nxt);
        const char* nA = has_next ? (const char*)g.A + (size_t)nxt.pm * tstep : cA; const char* nB = has_next ? (const char*)g.Bt + (size_t)nxt.pn * tstep : cB;
        for (int t = 0; t < nt; t += 2) {
            const bool last = (t == nt - 2);
            const char* a1 = cA + (size_t)(t + 1) * kstep;
            const char* a2 = last ? nA : cA + (size_t)(t + 2) * kstep; const char* b2 = last ? nB : cB + (size_t)(t + 2) * kstep;
            const char* a3 = a2 + kstep; const char* b3 = b2 + kstep;
            if (last && has_next) S.a_ready(nxt);
            if constexpr (SP2) {
            PG8_LDB(B0, 0, 0); PG8_LDB(B1, 0, 1); PG8_SCHED; PG8_LDA(At, 0, 0); PG8_STAGE(PG8_SA(1, 1), a1 + hstep, voffA);
            PG8_WAIT_V(8); PG8_WAIT_L(0); PG8_BAR; PG8_MMA(0, 0, At, B0); PG8_MMA(0, 1, At, B1); PG8_BAR; PG8_SCHED;
            PG8_LDA(At, 0, 1); PG8_STAGE(PG8_SB(0, 0), b2, voffB); PG8_STAGE(PG8_SB(0, 1), b2 + hstep, voffB); PG8_STAGE(PG8_SA(0, 0), a2, voffA);
            PG8_WAIT_V(8); PG8_WAIT_L(0); PG8_BAR; PG8_MMA(1, 0, At, B0); PG8_MMA(1, 1, At, B1); PG8_BAR; PG8_SCHED;
            PG8_LDB(B0, 1, 0); PG8_LDB(B1, 1, 1); PG8_SCHED; PG8_LDA(At, 1, 0); PG8_STAGE(PG8_SA(0, 1), a2 + hstep, voffA);
            PG8_WAIT_V(8); PG8_WAIT_L(0); PG8_BAR; PG8_MMA(0, 0, At, B0); PG8_MMA(0, 1, At, B1); PG8_BAR; PG8_SCHED;
            PG8_LDA(At, 1, 1); PG8_STAGE(PG8_SB(1, 0), b3, voffB); PG8_STAGE(PG8_SB(1, 1), b3 + hstep, voffB); PG8_STAGE(PG8_SA(1, 0), a3, voffA);
            PG8_WAIT_V(8); PG8_WAIT_L(0); PG8_BAR; PG8_MMA(1, 0, At, B0); PG8_MMA(1, 1, At, B1); PG8_BAR; PG8_SCHED;
            } else {
            PG8_LDB(B0, 0, 0); PG8_SCHED; PG8_LDA(At, 0, 0); PG8_STAGE(PG8_SA(1, 1), a1 + hstep, voffA);
            PG8_WAIT_L(8); PG8_BAR; PG8_WAIT_L(0); PG8_MMA(0, 0, At, B0); PG8_BAR; PG8_SCHED;
            PG8_LDB(B1, 0, 1); PG8_STAGE(PG8_SB(0, 0), b2, voffB);
            PG8_BAR; PG8_WAIT_L(0); PG8_MMA(0, 1, At, B1); PG8_BAR;
            PG8_LDA(At, 0, 1); PG8_STAGE(PG8_SA(0, 0), a2, voffA);
            PG8_BAR; PG8_WAIT_L(0); PG8_MMA(1, 0, At, B0); PG8_BAR; PG8_SCHED;
            PG8_STAGE(PG8_SB(0, 1), b2 + hstep, voffB);
            PG8_WAIT_V(6); PG8_BAR; PG8_MMA(1, 1, At, B1); PG8_BAR;
            PG8_LDB(B0, 1, 0); PG8_SCHED; PG8_LDA(At, 1, 0); PG8_STAGE(PG8_SA(0, 1), a2 + hstep, voffA);
            PG8_WAIT_L(8); PG8_BAR; PG8_WAIT_L(0); PG8_MMA(0, 0, At, B0); PG8_BAR; PG8_SCHED;
            PG8_LDB(B1, 1, 1); PG8_STAGE(PG8_SB(1, 0), b3, voffB);
            PG8_BAR; PG8_WAIT_L(0); PG8_MMA(0, 1, At, B1); PG8_BAR;
            PG8_LDA(At, 1, 1); PG8_STAGE(PG8_SA(1, 0), a3, voffA);
            PG8_BAR; PG8_WAIT_L(0); PG8_MMA(1, 0, At, B0); PG8_BAR; PG8_SCHED;
            PG8_STAGE(PG8_SB(1, 1), b3 + hstep, voffB);
            PG8_WAIT_V(6); PG8_BAR; PG8_MMA(1, 1, At, B1); PG8_BAR;
            }
        }
        if constexpr (ALIGN_EPI) { if (wr == 0) PG8_BAR; }
        if constexpr (!Epi::AFTER_DRAIN) { E(acc, cur, wr, wc, fr, fq); S.done(cur); }
        if (!has_next) break;
#pragma unroll
        for (int a = 0; a < 2; ++a)
#pragma unroll
            for (int b = 0; b < 2; ++b)
#pragma unroll
                for (int m = 0; m < 4; ++m)
#pragma unroll
                    for (int n = 0; n < 2; ++n) acc[a][b][m][n] = (f32x4){0.f, 0.f, 0.f, 0.f};
        cur = nxt; cA = nA; cB = nB; ++ui;
        if constexpr (ALIGN_EPI) { if (wr == 1) PG8_BAR; }
    }
    PG8_WAIT_V(0);
    if constexpr (!ALIGN_EPI) { if (wr == 0) PG8_BAR; }
    PG8_BAR;
    if constexpr (Epi::AFTER_DRAIN) { E.fused(acc, cur, wr, wc, fr, fq, lds, wid, lane); S.done(cur); }
#undef PG8_SA
#undef PG8_SB
#undef PG8_STAGE
#undef PG8_LDA
#undef PG8_LDB
#undef PG8_MMA
#undef PG8_WAIT_V
#undef PG8_WAIT_L
#undef PG8_BAR
#undef PG8_SCHED
}
}

#define LAS __attribute__((address_space(3)))
typedef unsigned short bf16;
typedef float f32x4 __attribute__((ext_vector_type(4)));
typedef short bf16x8 __attribute__((ext_vector_type(8)));
typedef unsigned u32x4 __attribute__((ext_vector_type(4)));
typedef unsigned u32x2 __attribute__((ext_vector_type(2)));

constexpr int DM = 1024, NB = 4, SEQ = 4096, MP = NB * SEQ, DB = 128, DSQ = 4, MS = DB * DSQ, M = MP + MS;
constexpr int DATT = 768, DINNER = 768, CONVD = 1792, NIN = 4864, NINTOT = 4876, DMIX = 1536, DFF = 2816, NGU = 5632;
constexpr int NH = 12, NCH = 32;
constexpr float EPS = 1e-5f, ATT_SCALE = 0.125f, LOG2E = 1.4426950408889634f, LN2 = 0.6931471805599453f;

constexpr size_t O_YP = 0, O_YS = O_YP + (size_t)MP * DM, O_PKV1 = O_YS + (size_t)MS * DM, O_PKV4 = O_PKV1 + (size_t)NB * 128 * 512, O_PKV16 = O_PKV4 + (size_t)NB * 512 * 512,
                 O_PCONV = O_PKV16 + (size_t)NB * 2048 * 512, O_PSSM = O_PCONV + (size_t)NB * 3 * CONVD, O_SKV1 = O_PSSM + (size_t)NB * NH * 64 * 128, O_SKV4 = O_SKV1 + (size_t)DB * 128 * 512,
                 O_SKV16 = O_SKV4 + (size_t)DB * 512 * 512, O_SCONV = O_SKV16 + (size_t)DB * 2048 * 512, O_SSSM = O_SCONV + (size_t)DB * 3 * CONVD, O_END = O_SSSM + (size_t)DB * NH * 64 * 128;
static_assert(O_YS == (size_t)MP * DM, "y rows contiguous");

constexpr size_t al256(size_t x) { return (x + 255) & ~(size_t)255; }
constexpr size_t WS_CTL = 0, CTL_BYTES = 65536;
constexpr size_t WS_WIN = CTL_BYTES;
constexpr size_t WS_WO = al256(WS_WIN + (size_t)NIN * DM * 2);
constexpr size_t WS_WGU = al256(WS_WO + (size_t)DM * DMIX * 2);
constexpr size_t WS_WD = al256(WS_WGU + (size_t)NGU * DM * 2);
constexpr size_t WS_XN = al256(WS_WD + (size_t)DM * DFF * 2);
constexpr size_t WS_DT = al256(WS_XN + (size_t)M * DM * 2);
constexpr size_t WS_Q = al256(WS_DT + (size_t)M * 12 * 4);
constexpr size_t WS_K = al256(WS_Q + (size_t)NB * 12 * SEQ * 64 * 2);
constexpr size_t WS_V = al256(WS_K + (size_t)NB * 12 * SEQ * 64 * 2);
constexpr size_t WS_QS = al256(WS_V + (size_t)NB * 12 * SEQ * 64 * 2);
constexpr size_t WS_Z = al256(WS_QS + (size_t)MS * DATT * 4);
constexpr size_t WS_XBC = al256(WS_Z + (size_t)M * DINNER * 2);
constexpr size_t WS_MIX = al256(WS_XBC + (size_t)M * CONVD * 2);
constexpr size_t WS_LSE = al256(WS_MIX + (size_t)M * DMIX * 2);
constexpr size_t WS_SLOC = al256(WS_LSE + (size_t)M * 12 * 4);
constexpr size_t WS_HPREV = al256(WS_SLOC + (size_t)NB * NCH * NH * 64 * 128 * 4);
constexpr size_t WS_CD = al256(WS_HPREV + (size_t)NB * NCH * NH * 64 * 128 * 2);
constexpr size_t WS_H = al256(WS_CD + (size_t)NB * NCH * NH * 4);
constexpr size_t WS_ACT = al256(WS_H + (size_t)M * DM * 4);
constexpr size_t WS_SS1 = al256(WS_ACT + (size_t)M * DFF * 2);
constexpr size_t WS_SS2 = al256(WS_SS1 + (size_t)M * 4);
constexpr size_t WS_XC = al256(WS_SS2 + (size_t)M * 4);
constexpr size_t WS_END = al256(WS_XC + (size_t)MP * CONVD * 2);

constexpr int BAR_LDS_OFF = 139264;
constexpr int LDS_BYTES = 147456;

typedef float f32x2_t __attribute__((ext_vector_type(2)));
typedef __bf16 bf16x2_t __attribute__((ext_vector_type(2)));
__device__ __forceinline__ unsigned cvtpk(float lo, float hi) { f32x2_t v = {lo, hi}; bf16x2_t b = __builtin_convertvector(v, bf16x2_t); return __builtin_bit_cast(unsigned, b); }
__device__ __forceinline__ float bflo(unsigned u) { return __uint_as_float(u << 16); }
__device__ __forceinline__ float bfhi(unsigned u) { return __uint_as_float(u & 0xffff0000u); }
__device__ __forceinline__ float bf2f(bf16 h) { return __uint_as_float((unsigned)h << 16); }
__device__ __forceinline__ float silu_f(float x) { return x / (1.0f + __expf(-x)); }
__device__ __forceinline__ float softplus_f(float x) { return x > 20.f ? x : log1pf(__expf(x)); }
__device__ __forceinline__ float wave_sum(float v) {
#pragma unroll
    for (int o = 1; o < 64; o <<= 1) v += __shfl_xor(v, o);
    return v;
}
__device__ __forceinline__ float wave_max(float v) {
#pragma unroll
    for (int o = 1; o < 64; o <<= 1) v = fmaxf(v, __shfl_xor(v, o));
    return v;
}
#define LDS_WAIT() asm volatile("s_waitcnt lgkmcnt(0)" ::: "memory")
__device__ __forceinline__ f32x4 mfma16(bf16x8 a, bf16x8 b, f32x4 c) { return __builtin_amdgcn_mfma_f32_16x16x32_bf16(a, b, c, 0, 0, 0); }
__device__ __forceinline__ bf16x8 mk8(unsigned a, unsigned b, unsigned c, unsigned d) { u32x4 v = {a, b, c, d}; return __builtin_bit_cast(bf16x8, v); }
__device__ __forceinline__ float dot4(f32x4 a, f32x4 b) { return (a.x * b.x + a.y * b.y) + (a.z * b.z + a.w * b.w); }

struct Params {
    const float* in[20];
    float* out;
    unsigned char* ws;
};
enum { I_XP = 0, I_XS, I_C1, I_C4, I_C16, I_SCONV, I_SSSM, I_NMIX, I_WIN, I_CW, I_CB, I_DTB, I_ALOG, I_DSKIP, I_NSSD, I_WOUT, I_NFFN, I_WGU, I_WD, I_NFIN };

struct EpiIn {
    static constexpr bool PERM = true, AFTER_DRAIN = false;
    bf16 *Q, *K, *V, *Z, *XBC; float* QS; float* out;
    __device__ __forceinline__ void operator()(const f32x4 (&acc)[2][2][4][2], const pg8::Unit& u, int wr, int wc, int fr, int fq) const {
        const int pn = u.pn; const bool sample = u.pm >= MP / 256;
#pragma unroll
        for (int ai = 0; ai < 2; ++ai)
#pragma unroll
            for (int m = 0; m < 4; ++m) {
                const int row = u.pm * 256 + ai * 128 + wr * 64 + m * 16 + fr;
#pragma unroll
                for (int bj = 0; bj < 2; ++bj) {
                    const int c0 = bj * 128 + wc * 32 + 8 * fq;
                    f32x4 v0 = acc[ai][bj][m][0], v1 = acc[ai][bj][m][1];
                    if (pn < 9) {
                        const int kind = pn / 3, g = pn % 3, j = c0 >> 6, d0 = c0 & 63, sh = 2 * g, win = 128 << sh;
                        if (!sample) {
                            const int b = row >> 12, t = row & 4095;
                            const int perm = (t & ((1 << sh) - 1)) * (SEQ >> sh) + (t >> sh);
                            const size_t off = ((size_t)((b * 3 + g) * 4 + j) * SEQ + perm) * 64 + d0;
                            if (kind == 0) { v0 = v0 * (ATT_SCALE * LOG2E); v1 = v1 * (ATT_SCALE * LOG2E); }
                            u32x4 w; w.x = cvtpk(v0[0], v0[1]); w.y = cvtpk(v0[2], v0[3]); w.z = cvtpk(v1[0], v1[1]); w.w = cvtpk(v1[2], v1[3]);
                            bf16* dst = kind == 0 ? Q : (kind == 1 ? K : V);
                            *(u32x4*)(dst + off) = w;
                            if (kind != 0 && t >= SEQ - win) {
                                const size_t ob = (g == 0 ? O_PKV1 : (g == 1 ? O_PKV4 : O_PKV16));
                                float* o = out + ob + ((((size_t)b * win + (t - (SEQ - win))) * 2 + (kind - 1)) * 4 + j) * 64 + d0;
                                *(f32x4*)o = acc[ai][bj][m][0]; *(f32x4*)(o + 4) = acc[ai][bj][m][1];
                            }
                        } else {
                            const int rs = row - MP, b = rs >> 2, s = rs & 3;
                            if (kind == 0) { float* o = QS + (size_t)rs * DATT + g * 256 + c0; *(f32x4*)o = v0; *(f32x4*)(o + 4) = v1; }
                            else {
                                const size_t ob = (g == 0 ? O_SKV1 : (g == 1 ? O_SKV4 : O_SKV16));
                                float* o = out + ob + ((((size_t)b * win + (win - 4 + s)) * 2 + (kind - 1)) * 4 + j) * 64 + d0;
                                *(f32x4*)o = v0; *(f32x4*)(o + 4) = v1;
                            }
                        }
                    } else {
                        u32x4 w; w.x = cvtpk(v0[0], v0[1]); w.y = cvtpk(v0[2], v0[3]); w.z = cvtpk(v1[0], v1[1]); w.w = cvtpk(v1[2], v1[3]);
                        if (pn < 12) { *(u32x4*)(Z + (size_t)row * DINNER + (pn - 9) * 256 + c0) = w; }
                        else {
                            const int col = (pn - 12) * 256 + c0;
                            *(u32x4*)(XBC + (size_t)row * CONVD + col) = w;
                            if (!sample) { const int b = row >> 12, t = row & 4095;
                                if (t >= SEQ - 3) { float* o = out + O_PCONV + ((size_t)b * 3 + (t - (SEQ - 3))) * CONVD + col; *(f32x4*)o = v0; *(f32x4*)(o + 4) = v1; } }
                            else { const int rs = row - MP, b = rs >> 2, s = rs & 3;
                                if (s >= 1) { float* o = out + O_SCONV + ((size_t)b * 3 + (s - 1)) * CONVD + col; *(f32x4*)o = v0; *(f32x4*)(o + 4) = v1; } }
                        }
                    }
                }
            }
    }
};

struct EpiOut {
    static constexpr bool PERM = false, AFTER_DRAIN = false;
    const float *xp, *xs, *gffn; float* H; bf16* HG; float* SS1;
    __device__ __forceinline__ void operator()(const f32x4 (&acc)[2][2][4][2], const pg8::Unit& u, int wr, int wc, int fr, int fq) const {
        const int colb = u.pn * 256 + wc * 32 + 4 * fq;
        f32x4 gv[2][2];
#pragma unroll
        for (int bj = 0; bj < 2; ++bj)
#pragma unroll
            for (int n = 0; n < 2; ++n) gv[bj][n] = *(const f32x4*)(gffn + colb + bj * 128 + n * 16);
#pragma unroll
        for (int ai = 0; ai < 2; ++ai) {
            f32x4 xv[4][2][2];
#pragma unroll
            for (int m = 0; m < 4; ++m) {
                const int row = u.pm * 256 + ai * 128 + wr * 64 + m * 16 + fr;
                const float* xrow = row < MP ? xp + (size_t)row * DM : xs + (size_t)(row - MP) * DM;
#pragma unroll
                for (int bj = 0; bj < 2; ++bj)
#pragma unroll
                    for (int n = 0; n < 2; ++n) xv[m][bj][n] = *(const f32x4*)(xrow + colb + bj * 128 + n * 16);
            }
#pragma unroll
            for (int m = 0; m < 4; ++m) {
                const int row = u.pm * 256 + ai * 128 + wr * 64 + m * 16 + fr;
                float ss = 0.f;
#pragma unroll
                for (int bj = 0; bj < 2; ++bj)
#pragma unroll
                    for (int n = 0; n < 2; ++n) {
                        const int col = colb + bj * 128 + n * 16;
                        const f32x4 hv = xv[m][bj][n] + acc[ai][bj][m][n];
                        *(f32x4*)(H + (size_t)row * DM + col) = hv; ss += dot4(hv, hv);
                        const f32x4 o = hv * gv[bj][n];
                        u32x2 w; w.x = cvtpk(o[0], o[1]); w.y = cvtpk(o[2], o[3]);
                        *(u32x2*)(HG + (size_t)row * DM + col) = w;
                    }
                ss += __shfl_xor(ss, 16); ss += __shfl_xor(ss, 32);
                if (fq == 0) atomicAdd(SS1 + row, ss);
            }
        }
    }
};

struct EpiGU {
    static constexpr bool PERM = true, AFTER_DRAIN = false;
    const float* SS1; bf16* ACT;
    __device__ __forceinline__ void operator()(const f32x4 (&acc)[2][2][4][2], const pg8::Unit& u, int wr, int wc, int fr, int fq) const {
#pragma unroll
        for (int ai = 0; ai < 2; ++ai)
#pragma unroll
            for (int m = 0; m < 4; ++m) {
                const int row = u.pm * 256 + ai * 128 + wr * 64 + m * 16 + fr;
                const float r = rsqrtf(SS1[row] * (1.0f / DM) + EPS);
#pragma unroll
                for (int bj = 0; bj < 2; ++bj) {
                    const int c0 = u.pn * 256 + bj * 128 + wc * 32 + 8 * fq;
                    const f32x4 gt = acc[ai][bj][m][0] * r, up = acc[ai][bj][m][1] * r;
                    f32x4 a; a.x = silu_f(gt.x) * up.x; a.y = silu_f(gt.y) * up.y; a.z = silu_f(gt.z) * up.z; a.w = silu_f(gt.w) * up.w;
                    u32x2 w; w.x = cvtpk(a[0], a[1]); w.y = cvtpk(a[2], a[3]);
                    *(u32x2*)(ACT + (size_t)row * DFF + (c0 >> 1)) = w;
                }
            }
    }
};

struct EpiDown {
    static constexpr bool PERM = false, AFTER_DRAIN = false;
    const float* H; float* Y; float* SS2;
    __device__ __forceinline__ void operator()(const f32x4 (&acc)[2][2][4][2], const pg8::Unit& u, int wr, int wc, int fr, int fq) const {
        const int colb = u.pn * 256 + wc * 32 + 4 * fq;
#pragma unroll
        for (int ai = 0; ai < 2; ++ai) {
            f32x4 hv[4][2][2];
#pragma unroll
            for (int m = 0; m < 4; ++m) {
                const int row = u.pm * 256 + ai * 128 + wr * 64 + m * 16 + fr;
#pragma unroll
                for (int bj = 0; bj < 2; ++bj)
#pragma unroll
                    for (int n = 0; n < 2; ++n) hv[m][bj][n] = *(const f32x4*)(H + (size_t)row * DM + colb + bj * 128 + n * 16);
            }
#pragma unroll
            for (int m = 0; m < 4; ++m) {
                const int row = u.pm * 256 + ai * 128 + wr * 64 + m * 16 + fr;
                float ss = 0.f;
#pragma unroll
                for (int bj = 0; bj < 2; ++bj)
#pragma unroll
                    for (int n = 0; n < 2; ++n) {
                        const f32x4 yv = hv[m][bj][n] + acc[ai][bj][m][n];
                        *(f32x4*)(Y + (size_t)row * DM + colb + bj * 128 + n * 16) = yv; ss += dot4(yv, yv);
                    }
                ss += __shfl_xor(ss, 16); ss += __shfl_xor(ss, 32);
                if (fq == 0) atomicAdd(SS2 + row, ss);
            }
        }
    }
};

__device__ __forceinline__ int gu_map(int n) { return n < DFF ? ((n >> 2) << 3) + (n & 3) : (((n - DFF) >> 2) << 3) + 4 + ((n - DFF) & 3); }

__device__ __forceinline__ void transpose_item(const float* __restrict__ W, int K, int ldn, int nblk, bf16* __restrict__ WT, int mode, LAS float* scr, int item, int lane) {
    const int kb = item / nblk, nb = item % nblk, k0 = 64 * kb, n0 = 32 * nb;
    float tv[32];
#pragma unroll
    for (int i = 0; i < 32; ++i) { const int kk = 2 * i + (lane >> 5); tv[i] = W[(size_t)(k0 + kk) * ldn + n0 + (lane & 31)]; }
#pragma unroll
    for (int i = 0; i < 32; ++i) { const int kk = 2 * i + (lane >> 5); scr[kk * 33 + (lane & 31)] = tv[i]; }
    LDS_WAIT();
    const int c = lane & 7;
#pragma unroll
    for (int j = 0; j < 4; ++j) { const int n = (lane >> 3) + 8 * j; const LAS float* s = scr + (8 * c) * 33 + n;
        u32x4 o; o.x = cvtpk(s[0 * 33], s[1 * 33]); o.y = cvtpk(s[2 * 33], s[3 * 33]); o.z = cvtpk(s[4 * 33], s[5 * 33]); o.w = cvtpk(s[6 * 33], s[7 * 33]);
        const int row = mode ? gu_map(n0 + n) : (n0 + n);
        *(u32x4*)(WT + (size_t)row * K + k0 + 8 * c) = o; }
    LDS_WAIT();
}

__device__ __forceinline__ void p0_prologue(const Params& P, LAS unsigned char* lds, int tid, int wave, int lane, int G) {
    unsigned char* ws = P.ws;
    LAS float* wdt = (LAS float*)lds;
    LAS float* scr = (LAS float*)(lds + 49152 + wave * 8704);
    const float* w_in = P.in[I_WIN];
    for (int i = tid; i < DM * 12; i += 512) { const int col = i / 12, h = i % 12; wdt[i] = w_in[(size_t)col * NINTOT + NIN + h]; }
    {
        float* ss1 = (float*)(ws + WS_SS1); float* ss2 = (float*)(ws + WS_SS2);
        for (int i = blockIdx.x * 512 + tid; i < M; i += G * 512) { ss1[i] = 0.f; ss2[i] = 0.f; }
    }
    const int gw = blockIdx.x * 8 + wave, NGW = G * 8;
    constexpr int I_IN = (DM / 64) * (NIN / 32), I_O = (DMIX / 64) * (DM / 32), I_GU = (DM / 64) * (NGU / 32), I_D = (DFF / 64) * (DM / 32);
#pragma unroll 1
    for (int it = gw; it < I_IN + I_O + I_GU + I_D; it += NGW) {
        int r = it;
        if (r < I_IN) { transpose_item(w_in, DM, NINTOT, NIN / 32, (bf16*)(ws + WS_WIN), 0, scr, r, lane); continue; } r -= I_IN;
        if (r < I_O) { transpose_item(P.in[I_WOUT], DMIX, DM, DM / 32, (bf16*)(ws + WS_WO), 0, scr, r, lane); continue; } r -= I_O;
        if (r < I_GU) { transpose_item(P.in[I_WGU], DM, NGU, NGU / 32, (bf16*)(ws + WS_WGU), 1, scr, r, lane); continue; } r -= I_GU;
        transpose_item(P.in[I_WD], DFF, DM, DM / 32, (bf16*)(ws + WS_WD), 0, scr, r, lane);
    }
    __syncthreads();
    const float* gmix = P.in[I_NMIX]; const float* dtb = P.in[I_DTB];
    bf16* XN = (bf16*)(ws + WS_XN); float* DT = (float*)(ws + WS_DT);
    f32x4 nv[4];
    if (gw < M) { const float* xr0 = gw < MP ? P.in[I_XP] + (size_t)gw * DM : P.in[I_XS] + (size_t)(gw - MP) * DM;
#pragma unroll
        for (int j = 0; j < 4; ++j) nv[j] = ((const f32x4*)xr0)[lane + 64 * j]; }
#pragma unroll 1
    for (int row = gw; row < M; row += NGW) {
        f32x4 v[4]; float ss = 0.f;
#pragma unroll
        for (int j = 0; j < 4; ++j) { v[j] = nv[j]; ss += dot4(v[j], v[j]); }
        { const int nr = row + NGW;
          if (nr < M) { const float* xr1 = nr < MP ? P.in[I_XP] + (size_t)nr * DM : P.in[I_XS] + (size_t)(nr - MP) * DM;
#pragma unroll
            for (int j = 0; j < 4; ++j) nv[j] = ((const f32x4*)xr1)[lane + 64 * j]; } }
        const float inv = rsqrtf(wave_sum(ss) * (1.0f / DM) + EPS);
        float pd[12];
#pragma unroll
        for (int h = 0; h < 12; ++h) pd[h] = 0.f;
#pragma unroll
        for (int j = 0; j < 4; ++j) {
            const f32x4 gv = ((const f32x4*)gmix)[lane + 64 * j];
            v[j] = v[j] * inv * gv;
            u32x2 w; w.x = cvtpk(v[j][0], v[j][1]); w.y = cvtpk(v[j][2], v[j][3]);
            *(u32x2*)(XN + (size_t)row * DM + 4 * (lane + 64 * j)) = w;
#pragma unroll
            for (int e = 0; e < 4; ++e) {
                const LAS f32x4* wp = (const LAS f32x4*)(wdt + (4 * (lane + 64 * j) + e) * 12);
                const f32x4 w0 = wp[0], w1 = wp[1], w2 = wp[2]; const float xv = v[j][e];
                pd[0] += xv * w0.x; pd[1] += xv * w0.y; pd[2] += xv * w0.z; pd[3] += xv * w0.w;
                pd[4] += xv * w1.x; pd[5] += xv * w1.y; pd[6] += xv * w1.z; pd[7] += xv * w1.w;
                pd[8] += xv * w2.x; pd[9] += xv * w2.y; pd[10] += xv * w2.z; pd[11] += xv * w2.w;
            }
            __builtin_amdgcn_sched_barrier(0);
        }
        float mine = 0.f;
#pragma unroll
        for (int h = 0; h < 12; ++h) { const float s = wave_sum(pd[h]); if (lane == h) mine = s; }
        if (lane < 12) DT[(size_t)row * 12 + lane] = softplus_f(mine + dtb[lane]);
    }
    __syncthreads();
}

__device__ __forceinline__ void attn_item(LAS unsigned char* lds, int item, const bf16* __restrict__ Qp, const bf16* __restrict__ Kp, const bf16* __restrict__ Vp,
                                          bf16* __restrict__ mixed, float* __restrict__ lse, int tid, int wave, int lane) {
    const int blk = item & 31, j = (item >> 5) & 3, g = (item >> 7) % 3, b = item / 384;
    const int sh = 2 * g, per_class = SEQ >> sh, nbc = per_class >> 7;
    const bool first = (blk & (nbc - 1)) == 0;
    const size_t headbase = (size_t)((b * 3 + g) * 4 + j) * SEQ * 64;
    const int fr = lane & 15, fq = lane >> 4;
    LAS unsigned char* Kl = lds;
    LAS bf16* Vt = (LAS bf16*)(lds + 36864);
    __syncthreads();
    {
        const bf16* Kb = Kp + headbase + ((size_t)blk * 128) * 64 - 128 * 64;
        const bf16* Vb = Vp + headbase + ((size_t)blk * 128) * 64 - 128 * 64;
#pragma unroll
        for (int i = 0; i < 4; ++i) {
            const int ci = tid + 512 * i, row = ci >> 3, c8 = ci & 7;
            u32x4 val = {0u, 0u, 0u, 0u};
            if (!(first && row < 128)) val = *(const u32x4*)(Kb + (size_t)row * 64 + c8 * 8);
            *(LAS u32x4*)(Kl + row * 144 + c8 * 16) = val;
        }
#pragma unroll
        for (int i = 0; i < 4; ++i) {
            const int row = lane + 64 * i, c8 = wave;
            u32x4 val = {0u, 0u, 0u, 0u};
            if (!(first && row < 128)) val = *(const u32x4*)(Vb + (size_t)row * 64 + c8 * 8);
            LAS bf16* d = Vt + (c8 * 8) * 264 + row;
            d[0 * 264] = (bf16)(val.x & 0xffff); d[1 * 264] = (bf16)(val.x >> 16);
            d[2 * 264] = (bf16)(val.y & 0xffff); d[3 * 264] = (bf16)(val.y >> 16);
            d[4 * 264] = (bf16)(val.z & 0xffff); d[5 * 264] = (bf16)(val.z >> 16);
            d[6 * 264] = (bf16)(val.w & 0xffff); d[7 * 264] = (bf16)(val.w >> 16);
        }
    }
    const bf16* Qb = Qp + headbase + (size_t)(blk * 128 + 16 * wave + fr) * 64;
    const bf16x8 qf0 = *(const bf16x8*)(Qb + fq * 8), qf1 = *(const bf16x8*)(Qb + 32 + fq * 8);
    __syncthreads();
    const int t0 = wave < 6 ? wave : 6;
    f32x4 s[10];
#pragma unroll
    for (int ti = 0; ti < 10; ++ti) {
        const int t = t0 + ti;
        const bf16x8 k0 = *(const LAS bf16x8*)(Kl + (t * 16 + fr) * 144 + fq * 16), k1 = *(const LAS bf16x8*)(Kl + (t * 16 + fr) * 144 + 64 + fq * 16);
        f32x4 a = {0.f, 0.f, 0.f, 0.f};
        a = mfma16(k0, qf0, a); a = mfma16(k1, qf1, a); s[ti] = a;
    }
    const int qi = 16 * wave + fr;
    float mx = -1e30f;
#pragma unroll
    for (int ti = 0; ti < 10; ++ti)
#pragma unroll
        for (int jj = 0; jj < 4; ++jj) {
            const int kj = (t0 + ti) * 16 + fq * 4 + jj, dist = 128 + qi - kj;
            const bool valid = dist >= 0 && dist <= 128 && (!first || kj >= 128);
            const float v = valid ? s[ti][jj] : -1e30f; s[ti][jj] = v; mx = fmaxf(mx, v);
        }
    mx = fmaxf(mx, __shfl_xor(mx, 16)); mx = fmaxf(mx, __shfl_xor(mx, 32));
    float den = 0.f;
#pragma unroll
    for (int ti = 0; ti < 10; ++ti)
#pragma unroll
        for (int jj = 0; jj < 4; ++jj) { const float p = exp2f(s[ti][jj] - mx); s[ti][jj] = p; den += p; }
    den += __shfl_xor(den, 16); den += __shfl_xor(den, 32);
    const float rden = 1.0f / den;
    f32x4 o[4];
#pragma unroll
    for (int dt = 0; dt < 4; ++dt) {
        f32x4 a = {0.f, 0.f, 0.f, 0.f};
#pragma unroll
        for (int i = 0; i < 5; ++i) {
            const LAS bf16* vr = Vt + (dt * 16 + fr) * 264 + (t0 + 2 * i) * 16 + fq * 4;
            const u32x2 lo = *(const LAS u32x2*)vr, hi = *(const LAS u32x2*)(vr + 16);
            const bf16x8 pf = mk8(cvtpk(s[2 * i][0], s[2 * i][1]), cvtpk(s[2 * i][2], s[2 * i][3]), cvtpk(s[2 * i + 1][0], s[2 * i + 1][1]), cvtpk(s[2 * i + 1][2], s[2 * i + 1][3]));
            a = mfma16(mk8(lo.x, lo.y, hi.x, hi.y), pf, a);
        }
        o[dt] = a * rden;
    }
    const int pp = blk * 128 + qi, cls = pp >> (12 - sh), ii = pp & (per_class - 1), pos = (ii << sh) + cls;
    const size_t row = (size_t)b * SEQ + pos;
#pragma unroll
    for (int dt = 0; dt < 4; ++dt) {
        u32x2 w; w.x = cvtpk(o[dt][0], o[dt][1]); w.y = cvtpk(o[dt][2], o[dt][3]);
        *(u32x2*)(mixed + row * DMIX + g * 256 + j * 64 + dt * 16 + fq * 4) = w;
    }
    if (fq == 0) lse[row * 12 + g * 4 + j] = (mx + log2f(den)) * LN2;
}

__device__ __forceinline__ void conv8(const bf16* __restrict__ xb, int t, int col, const float* __restrict__ cw, const float* __restrict__ cb, f32x4& lo, f32x4& hi) {
    f32x4 a0 = *(const f32x4*)(cb + col), a1 = *(const f32x4*)(cb + col + 4);
#pragma unroll
    for (int w = 0; w < 4; ++w) {
        const int tt = t - 3 + w;
        if (tt >= 0) {
            const u32x4 raw = *(const u32x4*)(xb + (size_t)tt * CONVD + col);
            const f32x4 w0 = *(const f32x4*)(cw + w * CONVD + col), w1 = *(const f32x4*)(cw + w * CONVD + col + 4);
            a0.x += bflo(raw.x) * w0.x; a0.y += bfhi(raw.x) * w0.y; a0.z += bflo(raw.y) * w0.z; a0.w += bfhi(raw.y) * w0.w;
            a1.x += bflo(raw.z) * w1.x; a1.y += bfhi(raw.z) * w1.y; a1.z += bflo(raw.w) * w1.z; a1.w += bfhi(raw.w) * w1.w;
        }
    }
    lo.x = silu_f(a0.x); lo.y = silu_f(a0.y); lo.z = silu_f(a0.z); lo.w = silu_f(a0.w);
    hi.x = silu_f(a1.x); hi.y = silu_f(a1.y); hi.z = silu_f(a1.z); hi.w = silu_f(a1.w);
}

__device__ __forceinline__ void scan128(float v0, float v1, int lane, float& i0, float& i1, float& total) {
    float s = v0 + v1;
#pragma unroll
    for (int o = 1; o < 64; o <<= 1) { const float t = __shfl_up(s, o); if (lane >= o) s += t; }
    i1 = s; i0 = s - v1; total = __shfl(s, 63);
}

__device__ __forceinline__ void ssd_passA_item(LAS unsigned char* lds, int item, const Params& P, int tid, int wave, int lane) {
    const int g = item & 3, c = (item >> 2) & 31, b = item >> 7;
    unsigned char* ws = P.ws;
    const bf16* xb = (const bf16*)(ws + WS_XBC) + (size_t)b * SEQ * CONVD;
    bf16* xcb = (bf16*)(ws + WS_XC) + (size_t)b * SEQ * CONVD;
    const float* DT = (const float*)(ws + WS_DT);
    float* SLOC = (float*)(ws + WS_SLOC); float* CD = (float*)(ws + WS_CD);
    const float* cw = P.in[I_CW]; const float* cb = P.in[I_CB];
    LAS float* tabw = (LAS float*)lds;
    LAS bf16* xT = (LAS bf16*)(lds + 2048);
    LAS bf16* BT = (LAS bf16*)(lds + 2048 + 52224);
    const int fr = lane & 15, fq = lane >> 4;
    const int oct = tid % 56, seg = tid / 56, l0 = seg * 16;
    const int col = oct < 24 ? g * 192 + oct * 8 : (oct < 40 ? DINNER + g * 128 + (oct - 24) * 8 : DINNER + 512 + g * 128 + (oct - 40) * 8);
    const int t0 = c * 128 + l0;
    __syncthreads();
    if (wave < 3) {
        const int h = g * 3 + wave; const float a = -__expf(P.in[I_ALOG][h]);
        const size_t r0 = (size_t)b * SEQ + c * 128 + 2 * lane;
        const float d0 = DT[r0 * 12 + h], d1 = DT[(r0 + 1) * 12 + h];
        float i0, i1, tot; scan128(d0 * a, d1 * a, lane, i0, i1, tot);
        tabw[wave * 128 + 2 * lane] = __expf(tot - i0) * d0; tabw[wave * 128 + 2 * lane + 1] = __expf(tot - i1) * d1;
        if (lane == 0) CD[(b * NCH + c) * NH + h] = __expf(tot);
    }
    __syncthreads();
    if (tid < 448) {
        f32x4 wv[4][2], bias[2];
#pragma unroll
        for (int w = 0; w < 4; ++w) { wv[w][0] = *(const f32x4*)(cw + w * CONVD + col); wv[w][1] = *(const f32x4*)(cw + w * CONVD + col + 4); }
        bias[0] = *(const f32x4*)(cb + col); bias[1] = *(const f32x4*)(cb + col + 4);
        const int hh = oct >> 3;
        LAS bf16* dT = oct < 24 ? xT + (hh * 64 + (oct & 7) * 8) * 136 + l0 : BT + ((oct - 24) * 8) * 136 + l0;
#pragma unroll 1
        for (int half = 0; half < 4; ++half) {
            const int th = t0 + 4 * half;
            u32x4 raw[7];
#pragma unroll
            for (int r = 0; r < 7; ++r) { const int tt = th - 3 + r; raw[r] = (u32x4){0u, 0u, 0u, 0u}; if (tt >= 0) raw[r] = *(const u32x4*)(xb + (size_t)tt * CONVD + col); }
#pragma unroll
            for (int lp = 0; lp < 2; ++lp) {
                f32x4 o[2][2];
#pragma unroll
                for (int q = 0; q < 2; ++q) {
                    f32x4 a0 = bias[0], a1 = bias[1];
#pragma unroll
                    for (int w = 0; w < 4; ++w) {
                        const u32x4 r = raw[2 * lp + q + w];
                        a0.x += bflo(r.x) * wv[w][0].x; a0.y += bfhi(r.x) * wv[w][0].y; a0.z += bflo(r.y) * wv[w][0].z; a0.w += bfhi(r.y) * wv[w][0].w;
                        a1.x += bflo(r.z) * wv[w][1].x; a1.y += bfhi(r.z) * wv[w][1].y; a1.z += bflo(r.w) * wv[w][1].z; a1.w += bfhi(r.w) * wv[w][1].w;
                    }
                    o[q][0] = (f32x4){silu_f(a0.x), silu_f(a0.y), silu_f(a0.z), silu_f(a0.w)};
                    o[q][1] = (f32x4){silu_f(a1.x), silu_f(a1.y), silu_f(a1.z), silu_f(a1.w)};
                    u32x4 w4; w4.x = cvtpk(o[q][0].x, o[q][0].y); w4.y = cvtpk(o[q][0].z, o[q][0].w); w4.z = cvtpk(o[q][1].x, o[q][1].y); w4.w = cvtpk(o[q][1].z, o[q][1].w);
                    *(u32x4*)(xcb + (size_t)(th + 2 * lp + q) * CONVD + col) = w4;
                }
                if (oct < 40) {
                    const int lo2 = 4 * half + 2 * lp;
                    float s0 = 1.f, s1 = 1.f;
                    if (oct < 24) { s0 = tabw[hh * 128 + l0 + lo2]; s1 = tabw[hh * 128 + l0 + lo2 + 1]; }
                    LAS unsigned* d = (LAS unsigned*)(dT + lo2);
                    d[0 * 68] = cvtpk(o[0][0].x * s0, o[1][0].x * s1); d[1 * 68] = cvtpk(o[0][0].y * s0, o[1][0].y * s1);
                    d[2 * 68] = cvtpk(o[0][0].z * s0, o[1][0].z * s1); d[3 * 68] = cvtpk(o[0][0].w * s0, o[1][0].w * s1);
                    d[4 * 68] = cvtpk(o[0][1].x * s0, o[1][1].x * s1); d[5 * 68] = cvtpk(o[0][1].y * s0, o[1][1].y * s1);
                    d[6 * 68] = cvtpk(o[0][1].z * s0, o[1][1].z * s1); d[7 * 68] = cvtpk(o[0][1].w * s0, o[1][1].w * s1);
                }
            }
        }
    }
    __syncthreads();
    bf16x8 bfr[4];
#pragma unroll
    for (int ks = 0; ks < 4; ++ks) bfr[ks] = *(const LAS bf16x8*)(BT + (wave * 16 + fr) * 136 + ks * 32 + fq * 8);
#pragma unroll
    for (int hh = 0; hh < 3; ++hh)
#pragma unroll
        for (int pt = 0; pt < 4; ++pt) {
            f32x4 acc = {0.f, 0.f, 0.f, 0.f};
#pragma unroll
            for (int ks = 0; ks < 4; ++ks) acc = mfma16(*(const LAS bf16x8*)(xT + (hh * 64 + pt * 16 + fr) * 136 + ks * 32 + fq * 8), bfr[ks], acc);
            float* dst = SLOC + ((((size_t)(b * NCH + c) * NH + g * 3 + hh) * 64 + pt * 16 + fq * 4) * 128) + wave * 16 + fr;
#pragma unroll
            for (int jj = 0; jj < 4; ++jj) dst[jj * 128] = acc[jj];
        }
}

__device__ __forceinline__ void ssd_sample_item(LAS unsigned char* lds, int b, const Params& P, int tid, int wave, int lane) {
    unsigned char* ws = P.ws;
    const bf16* XBC = (const bf16*)(ws + WS_XBC); const bf16* Z = (const bf16*)(ws + WS_Z); const float* DT = (const float*)(ws + WS_DT);
    bf16* mixed = (bf16*)(ws + WS_MIX);
    const float* cw = P.in[I_CW]; const float* cb = P.in[I_CB]; const float* sconv = P.in[I_SCONV]; const float* sssm = P.in[I_SSSM];
    float* out_ssm = P.out + O_SSSM;
    LAS float* xc = (LAS float*)lds;
    LAS float* dts = (LAS float*)(lds + 28672);
    LAS float* yg = (LAS float*)(lds + 28928);
    __syncthreads();
    if (tid < CONVD / 8) {
        const int col = tid * 8;
        f32x4 xin[7][2];
#pragma unroll
        for (int r = 0; r < 3; ++r) { const float* sp = sconv + ((size_t)b * 3 + r) * CONVD + col; xin[r][0] = *(const f32x4*)sp; xin[r][1] = *(const f32x4*)(sp + 4); }
#pragma unroll
        for (int r = 0; r < 4; ++r) { const u32x4 v = *(const u32x4*)(XBC + ((size_t)MP + b * 4 + r) * CONVD + col);
            xin[3 + r][0] = (f32x4){bflo(v.x), bfhi(v.x), bflo(v.y), bfhi(v.y)}; xin[3 + r][1] = (f32x4){bflo(v.z), bfhi(v.z), bflo(v.w), bfhi(v.w)}; }
        f32x4 wv[4][2];
#pragma unroll
        for (int w = 0; w < 4; ++w) { wv[w][0] = *(const f32x4*)(cw + w * CONVD + col); wv[w][1] = *(const f32x4*)(cw + w * CONVD + col + 4); }
        const f32x4 b0 = *(const f32x4*)(cb + col), b1 = *(const f32x4*)(cb + col + 4);
#pragma unroll
        for (int s = 0; s < 4; ++s) {
            f32x4 a0 = b0, a1 = b1;
#pragma unroll
            for (int w = 0; w < 4; ++w) { a0 += xin[s + w][0] * wv[w][0]; a1 += xin[s + w][1] * wv[w][1]; }
            *(LAS f32x4*)(xc + s * CONVD + col) = (f32x4){silu_f(a0.x), silu_f(a0.y), silu_f(a0.z), silu_f(a0.w)};
            *(LAS f32x4*)(xc + s * CONVD + col + 4) = (f32x4){silu_f(a1.x), silu_f(a1.y), silu_f(a1.z), silu_f(a1.w)};
        }
    }
    if (tid < 48) dts[tid] = DT[((size_t)MP + b * 4 + tid / 12) * 12 + tid % 12];
    LAS float* zs = (LAS float*)(lds + 41216);
    for (int i = tid; i < 4 * DINNER / 2; i += 512) { const unsigned zz = *(const unsigned*)(Z + ((size_t)MP + b * 4) * DINNER + 2 * i); zs[2 * i] = bflo(zz); zs[2 * i + 1] = bfhi(zz); }
    __syncthreads();
    const int p = tid >> 3, nq = tid & 7, n0 = nq * 16;
    f32x4 nx[4];
#pragma unroll
    for (int i = 0; i < 4; ++i) nx[i] = __builtin_nontemporal_load((const f32x4*)(sssm + ((size_t)(b * NH) * 64 + p) * 128 + n0 + 4 * i));
#pragma unroll 1
    for (int h = 0; h < NH; ++h) {
        const int g = h / 3;
        const size_t so = ((size_t)(b * NH + h) * 64 + p) * 128 + n0;
        f32x4 st[4];
#pragma unroll
        for (int i = 0; i < 4; ++i) st[i] = nx[i];
        if (h + 1 < NH) {
#pragma unroll
            for (int i = 0; i < 4; ++i) nx[i] = __builtin_nontemporal_load((const f32x4*)(sssm + so + 64 * 128 + 4 * i));
        }
        const float a = -__expf(P.in[I_ALOG][h]), Dh = P.in[I_DSKIP][h];
#pragma unroll
        for (int s = 0; s < 4; ++s) {
            const float dt = dts[s * 12 + h], dA = __expf(dt * a), xv = xc[s * CONVD + h * 64 + p], xdt = xv * dt;
            const LAS f32x4* Bv = (const LAS f32x4*)(xc + s * CONVD + DINNER + g * 128 + n0);
            const LAS f32x4* Cv = (const LAS f32x4*)(xc + s * CONVD + DINNER + 512 + g * 128 + n0);
            float y = 0.f;
#pragma unroll
            for (int i = 0; i < 4; ++i) { st[i] = st[i] * dA + Bv[i] * xdt; y += dot4(Cv[i], st[i]); }
            y += __shfl_xor(y, 1); y += __shfl_xor(y, 2); y += __shfl_xor(y, 4);
            if (nq == 0) { const float z = zs[s * DINNER + h * 64 + p]; yg[s * DINNER + h * 64 + p] = (y + Dh * xv) * silu_f(z); }
        }
#pragma unroll
        for (int i = 0; i < 4; ++i) __builtin_nontemporal_store(st[i], (f32x4*)(out_ssm + so + 4 * i));
    }
    __syncthreads();
    if (wave < 4) {
        const int s = wave; float ss = 0.f;
#pragma unroll
        for (int k = 0; k < 12; ++k) { const float v = yg[s * DINNER + lane + 64 * k]; ss += v * v; }
        const float inv = rsqrtf(wave_sum(ss) * (1.0f / DINNER) + EPS);
        const float* gs = P.in[I_NSSD];
#pragma unroll
        for (int k = 0; k < 12; ++k) { const int cc = lane + 64 * k; const float v = yg[s * DINNER + cc] * inv * gs[cc];
            mixed[((size_t)MP + b * 4 + s) * DMIX + DATT + cc] = (bf16)(cvtpk(v, 0.f) & 0xffff); }
    }
}

__device__ __forceinline__ const float* kv_row(const float* cache, const float* skv, int b, int lb, int idx) {
    return idx < lb ? cache + ((size_t)b * lb + idx) * 512 : skv + ((size_t)b * lb + (idx - 4)) * 512;
}
__device__ __forceinline__ void attn_sample_item(LAS unsigned char* lds, int item, const Params& P, int tid, int wave, int lane) {
    const int g = item % 3, b = item / 3;
    unsigned char* ws = P.ws;
    const float* QS = (const float*)(ws + WS_QS); bf16* mixed = (bf16*)(ws + WS_MIX); float* LSE = (float*)(ws + WS_LSE);
    LAS float* pl = (LAS float*)lds;
    const int sh = 2 * g, lb = 128 << sh;
    const float* cache = g == 0 ? P.in[I_C1] : (g == 1 ? P.in[I_C4] : P.in[I_C16]);
    const float* skv = P.out + (g == 0 ? O_SKV1 : (g == 1 ? O_SKV4 : O_SKV16));
    const int q4 = lane >> 4, l16 = lane & 15;
    __syncthreads();
#pragma unroll 1
    for (int k = 0; k < 2; ++k) {
        const int pi = wave * 2 + k, j = pi >> 2, s = pi & 3;
        const size_t row = (size_t)MP + b * 4 + s;
        {
            const f32x4 qv = *(const f32x4*)(QS + ((size_t)b * 4 + s) * DATT + g * 256 + j * 64 + l16 * 4) * ATT_SCALE;
#pragma unroll 1
            for (int bt = 0; bt < 3; ++bt) {
                f32x4 kv[11];
#pragma unroll
                for (int i = 0; i < 11; ++i) {
                    const int jj = (bt * 11 + i) * 4 + q4; int idx = lb + s - (jj << sh);
                    if (jj > 128 || idx < 0) idx = 0;
                    kv[i] = *(const f32x4*)(kv_row(cache, skv, b, lb, idx) + j * 64 + l16 * 4);
                }
#pragma unroll
                for (int i = 0; i < 11; ++i) {
                    const int jj = (bt * 11 + i) * 4 + q4; const int idx = lb + s - (jj << sh);
                    const bool valid = jj <= 128 && idx >= 0;
                    float d = dot4(kv[i], qv);
                    d += __shfl_xor(d, 1); d += __shfl_xor(d, 2); d += __shfl_xor(d, 4); d += __shfl_xor(d, 8);
                    pl[l16 == 0 ? wave * 132 + jj : 1056 + lane] = valid ? d : -1e30f;
                }
            }
        }
        LDS_WAIT();
        float sc[3];
#pragma unroll
        for (int u = 0; u < 3; ++u) { const int jj = lane + 64 * u; sc[u] = jj < 132 ? pl[wave * 132 + jj] : -1e30f; }
        const float mx = wave_max(fmaxf(fmaxf(sc[0], sc[1]), sc[2]));
        float den = 0.f;
#pragma unroll
        for (int u = 0; u < 3; ++u) { const int jj = lane + 64 * u; const float p = sc[u] > -1e29f ? __expf(sc[u] - mx) : 0.f; den += p; if (jj < 132) pl[wave * 132 + jj] = p; }
        den = wave_sum(den);
        LDS_WAIT();
        f32x4 o = {0.f, 0.f, 0.f, 0.f};
        {
#pragma unroll 1
            for (int bt = 0; bt < 3; ++bt) {
                f32x4 vv[11];
#pragma unroll
                for (int i = 0; i < 11; ++i) {
                    const int jj = (bt * 11 + i) * 4 + q4; int idx = lb + s - (jj << sh); if (jj > 128 || idx < 0) idx = 0;
                    vv[i] = *(const f32x4*)(kv_row(cache, skv, b, lb, idx) + 256 + j * 64 + l16 * 4);
                }
#pragma unroll
                for (int i = 0; i < 11; ++i) o += vv[i] * pl[wave * 132 + (bt * 11 + i) * 4 + q4];
            }
        }
#pragma unroll
        for (int e = 0; e < 4; ++e) { o[e] += __shfl_xor(o[e], 16); o[e] += __shfl_xor(o[e], 32); }
        o = o * (1.0f / den);
        if (q4 == 0) { u32x2 w; w.x = cvtpk(o[0], o[1]); w.y = cvtpk(o[2], o[3]); *(u32x2*)(mixed + row * DMIX + g * 256 + j * 64 + l16 * 4) = w; }
        if (lane == 0) LSE[row * 12 + g * 4 + j] = mx + __logf(den);
        LDS_WAIT();
    }
}

constexpr int NCOPY = DB * (2 + 8 + 32);
struct CopyDesc { const f32x4* src; f32x4* dst; int n4; };
__device__ __forceinline__ CopyDesc copy_desc(int ci, const Params& P) {
    int g, b, ch;
    if (ci < DB * 2) { g = 0; b = ci >> 1; ch = ci & 1; }
    else if (ci < DB * 10) { ci -= DB * 2; g = 1; b = ci >> 3; ch = ci & 7; }
    else { ci -= DB * 10; g = 2; b = ci >> 5; ch = ci & 31; }
    const int lb = 128 << (2 * g), row0 = ch * 64;
    int nrows = lb - 4 - row0; if (nrows > 64) nrows = 64;
    CopyDesc d;
    d.src = (const f32x4*)((g == 0 ? P.in[I_C1] : (g == 1 ? P.in[I_C4] : P.in[I_C16])) + ((size_t)b * lb + 4 + row0) * 512);
    d.dst = (f32x4*)(P.out + (g == 0 ? O_SKV1 : (g == 1 ? O_SKV4 : O_SKV16)) + ((size_t)b * lb + row0) * 512);
    d.n4 = nrows * 128;
    return d;
}

__device__ __forceinline__ void p2b_scan(const Params& P, int tid, int G) {
    unsigned char* ws = P.ws;
    const float* __restrict__ SLOC = (const float*)(ws + WS_SLOC); const float* __restrict__ CD = (const float*)(ws + WS_CD); bf16* __restrict__ HP = (bf16*)(ws + WS_HPREV);
    float* __restrict__ pssm = P.out + O_PSSM;
    constexpr int NV = NB * NH * 64 * 32;
    for (int v = blockIdx.x * 512 + tid; v < NV; v += G * 512) {
        const int n4 = v & 31, p = (v >> 5) & 63, bh = v >> 11, b = bh / NH, h = bh % NH;
        f32x4 run = {0.f, 0.f, 0.f, 0.f};
#pragma unroll 8
        for (int c = 0; c < NCH; ++c) {
            const size_t off = (((size_t)(b * NCH + c) * NH + h) * 64 + p) * 128 + n4 * 4;
            const f32x4 sv = __builtin_nontemporal_load((const f32x4*)(SLOC + off)); const float cd = CD[(b * NCH + c) * NH + h];
            u32x2 w; w.x = cvtpk(run.x, run.y); w.y = cvtpk(run.z, run.w);
            *(u32x2*)(HP + off) = w;
            run = run * cd + sv;
        }
        *(f32x4*)(pssm + ((size_t)(b * NH + h) * 64 + p) * 128 + n4 * 4) = run;
    }
}

__device__ __forceinline__ void alpha_rows(bf16* __restrict__ mixed, const float* __restrict__ LSE, size_t r0, int tid) {
    u32x4 v[12]; float al[12];
#pragma unroll
    for (int i = 0; i < 12; ++i) {
        const int wi = tid + 512 * i, rr = wi / 96, oc = wi % 96, c0 = oc * 8, g = c0 >> 8, j = (c0 >> 6) & 3;
        const float* lp = LSE + (r0 + rr) * 12 + j;
        const float l0 = lp[0], l1 = lp[4], l2 = lp[8];
        v[i] = *(const u32x4*)(mixed + (r0 + rr) * DMIX + c0);
        const float mx = fmaxf(l0, fmaxf(l1, l2)), e0 = __expf(l0 - mx), e1 = __expf(l1 - mx), e2 = __expf(l2 - mx);
        al[i] = (g == 0 ? e0 : (g == 1 ? e1 : e2)) / (e0 + e1 + e2);
    }
#pragma unroll
    for (int i = 0; i < 12; ++i) {
        const int wi = tid + 512 * i, rr = wi / 96, oc = wi % 96, c0 = oc * 8; const float a = al[i];
        u32x4 w; w.x = cvtpk(bflo(v[i].x) * a, bfhi(v[i].x) * a); w.y = cvtpk(bflo(v[i].y) * a, bfhi(v[i].y) * a); w.z = cvtpk(bflo(v[i].z) * a, bfhi(v[i].z) * a); w.w = cvtpk(bflo(v[i].w) * a, bfhi(v[i].w) * a);
        *(u32x4*)(mixed + (r0 + rr) * DMIX + c0) = w;
    }
}

__device__ __forceinline__ void p2c_item(LAS unsigned char* lds, int item, const Params& P, int tid, int wave, int lane, bool do_alpha = true) {
    const int hf = item & 1, c = (item >> 1) & 31, b = item >> 6;
    unsigned char* ws = P.ws;
    const bf16* xcb = (const bf16*)(ws + WS_XC) + (size_t)b * SEQ * CONVD;
    const float* DT = (const float*)(ws + WS_DT); const bf16* HP = (const bf16*)(ws + WS_HPREV); const bf16* Z = (const bf16*)(ws + WS_Z);
    bf16* mixed = (bf16*)(ws + WS_MIX); const float* LSE = (const float*)(ws + WS_LSE);
    LAS bf16* Bn = (LAS bf16*)lds;
    LAS bf16* Cn = (LAS bf16*)(lds + 34816);
    LAS bf16* xT = (LAS bf16*)(lds + 52224);
    LAS float* tdt = (LAS float*)(lds + 104448);
    LAS float* tac = (LAS float*)(lds + 105984);
    LAS float* ssl = (LAS float*)(lds + 107520);
    const int fr = lane & 15, fq = lane >> 4, rt = wave & 3, ph = wave >> 2;
    const int smax = 64 * (hf + 1), lg = 64 * hf + 16 * rt + fr;
    const size_t row = (size_t)b * SEQ + c * 128 + lg;
    const int npairs = ((hf * 4 + rt) >> 1) + 1;
    float ssq = 0.f;
    for (int g = 0; g < 4; ++g) {
        __syncthreads();
        if (wave < 3) {
            const int h = g * 3 + wave; const float a = -__expf(P.in[I_ALOG][h]);
            const size_t r0 = (size_t)b * SEQ + c * 128 + 2 * lane;
            const float d0 = DT[r0 * 12 + h], d1 = DT[(r0 + 1) * 12 + h];
            float i0, i1, tot; scan128(d0 * a, d1 * a, lane, i0, i1, tot);
            tdt[wave * 128 + 2 * lane] = d0; tdt[wave * 128 + 2 * lane + 1] = d1;
            tac[wave * 128 + 2 * lane] = i0; tac[wave * 128 + 2 * lane + 1] = i1;
        }
        if (tid >= 192) {
            u32x4 sv[10];
#pragma unroll
            for (int i = 0; i < 10; ++i) {
                const int wi = tid - 192 + 320 * i; sv[i] = (u32x4){0u, 0u, 0u, 0u};
                if (wi < smax * 16) { const int oct = wi & 15, s = wi >> 4; sv[i] = *(const u32x4*)(xcb + (size_t)(c * 128 + s) * CONVD + DINNER + g * 128 + oct * 8); }
                else if (wi < smax * 16 + 1024) { const int w2 = wi - smax * 16, oct = w2 & 15, l = w2 >> 4; sv[i] = *(const u32x4*)(xcb + (size_t)(c * 128 + 64 * hf + l) * CONVD + DINNER + 512 + g * 128 + oct * 8); }
            }
#pragma unroll
            for (int i = 0; i < 10; ++i) {
                const int wi = tid - 192 + 320 * i;
                if (wi < smax * 16) { const int oct = wi & 15, s = wi >> 4; *(LAS u32x4*)(Bn + s * 136 + oct * 8) = sv[i]; }
                else if (wi < smax * 16 + 1024) { const int w2 = wi - smax * 16, oct = w2 & 15, l = w2 >> 4; *(LAS u32x4*)(Cn + l * 136 + oct * 8) = sv[i]; }
            }
        } else if (tid < 24 * (smax >> 4)) {
            const int oct = tid % 24, seg = tid / 24, s0 = seg * 16, hh = oct >> 3;
            u32x4 r[16];
#pragma unroll
            for (int i = 0; i < 16; ++i) r[i] = *(const u32x4*)(xcb + (size_t)(c * 128 + s0 + i) * CONVD + g * 192 + oct * 8);
            LAS unsigned* d = (LAS unsigned*)(xT + (hh * 64 + (oct & 7) * 8) * 136 + s0);
#pragma unroll
            for (int i = 0; i < 8; ++i) {
                const u32x4 a0 = r[2 * i], a1 = r[2 * i + 1];
                d[0 * 68 + i] = (a0.x & 0xffffu) | (a1.x << 16); d[1 * 68 + i] = (a0.x >> 16) | (a1.x & 0xffff0000u);
                d[2 * 68 + i] = (a0.y & 0xffffu) | (a1.y << 16); d[3 * 68 + i] = (a0.y >> 16) | (a1.y & 0xffff0000u);
                d[4 * 68 + i] = (a0.z & 0xffffu) | (a1.z << 16); d[5 * 68 + i] = (a0.z >> 16) | (a1.z & 0xffff0000u);
                d[6 * 68 + i] = (a0.w & 0xffffu) | (a1.w << 16); d[7 * 68 + i] = (a0.w >> 16) | (a1.w & 0xffff0000u);
            }
        }
        __syncthreads();
        bf16x8 cfr[4];
#pragma unroll
        for (int ks = 0; ks < 4; ++ks) cfr[ks] = *(const LAS bf16x8*)(Cn + (16 * rt + fr) * 136 + ks * 32 + fq * 8);
        f32x4 accY[3][2];
#pragma unroll
        for (int h = 0; h < 3; ++h) { accY[h][0] = (f32x4){0.f, 0.f, 0.f, 0.f}; accY[h][1] = (f32x4){0.f, 0.f, 0.f, 0.f}; }
        float acl[3];
#pragma unroll
        for (int h = 0; h < 3; ++h) acl[h] = tac[h * 128 + lg];
        const bf16* hpb = HP + ((((size_t)(b * NCH + c) * NH + g * 3) * 64 + 2 * ph * 16 + fr) * 128) + fq * 8;
        bf16x8 hpc[2][4];
#pragma unroll
        for (int pti = 0; pti < 2; ++pti)
#pragma unroll
            for (int ks = 0; ks < 4; ++ks) hpc[pti][ks] = *(const bf16x8*)(hpb + pti * 16 * 128 + ks * 32);
        for (int sp = 0; sp < npairs; ++sp) {
            f32x4 cbv[2];
#pragma unroll
            for (int u = 0; u < 2; ++u) {
                f32x4 a = {0.f, 0.f, 0.f, 0.f};
#pragma unroll
                for (int ks = 0; ks < 4; ++ks) a = mfma16(*(const LAS bf16x8*)(Bn + ((2 * sp + u) * 16 + fr) * 136 + ks * 32 + fq * 8), cfr[ks], a);
                cbv[u] = a;
            }
#pragma unroll
            for (int h = 0; h < 3; ++h) {
                float mv[8];
#pragma unroll
                for (int u = 0; u < 2; ++u) {
                    const int s0 = (2 * sp + u) * 16 + fq * 4;
                    const f32x4 as = *(const LAS f32x4*)(tac + h * 128 + s0), ds = *(const LAS f32x4*)(tdt + h * 128 + s0);
#pragma unroll
                    for (int jj = 0; jj < 4; ++jj) {
                        const float e = fminf(acl[h] - as[jj], 0.f);
                        mv[u * 4 + jj] = (s0 + jj <= lg) ? cbv[u][jj] * __expf(e) * ds[jj] : 0.f;
                    }
                }
                const bf16x8 pf = mk8(cvtpk(mv[0], mv[1]), cvtpk(mv[2], mv[3]), cvtpk(mv[4], mv[5]), cvtpk(mv[6], mv[7]));
#pragma unroll
                for (int pti = 0; pti < 2; ++pti) {
                    const LAS bf16* xr = xT + (h * 64 + (2 * ph + pti) * 16 + fr) * 136 + (2 * sp) * 16 + fq * 4;
                    const u32x2 lo = *(const LAS u32x2*)xr, hi = *(const LAS u32x2*)(xr + 16);
                    accY[h][pti] = mfma16(mk8(lo.x, lo.y, hi.x, hi.y), pf, accY[h][pti]);
                }
            }
        }
#pragma unroll
        for (int h = 0; h < 3; ++h) {
            const int hd = g * 3 + h; const float Dh = P.in[I_DSKIP][hd], eal = __expf(acl[h]);
            bf16x8 hpn[2][4];
            if (h < 2) {
#pragma unroll
                for (int pti = 0; pti < 2; ++pti)
#pragma unroll
                    for (int ks = 0; ks < 4; ++ks) hpn[pti][ks] = *(const bf16x8*)(hpb + (size_t)(h + 1) * 64 * 128 + pti * 16 * 128 + ks * 32);
            }
#pragma unroll
            for (int pti = 0; pti < 2; ++pti) {
                const int pt = 2 * ph + pti;
                f32x4 a = {0.f, 0.f, 0.f, 0.f};
#pragma unroll
                for (int ks = 0; ks < 4; ++ks) a = mfma16(hpc[pti][ks], cfr[ks], a);
                const f32x4 y = accY[h][pti] + a * eal;
                const int pc = hd * 64 + pt * 16 + fq * 4;
                const u32x2 zr = *(const u32x2*)(Z + row * DINNER + pc);
                const float z0 = bflo(zr.x), z1 = bfhi(zr.x), z2 = bflo(zr.y), z3 = bfhi(zr.y);
                const LAS bf16* xc = xT + (h * 64 + pt * 16 + fq * 4) * 136 + lg;
                const float y0 = (y[0] + Dh * bf2f(xc[0])) * silu_f(z0), y1 = (y[1] + Dh * bf2f(xc[136])) * silu_f(z1);
                const float y2 = (y[2] + Dh * bf2f(xc[2 * 136])) * silu_f(z2), y3 = (y[3] + Dh * bf2f(xc[3 * 136])) * silu_f(z3);
                ssq += (y0 * y0 + y1 * y1) + (y2 * y2 + y3 * y3);
                u32x2 w; w.x = cvtpk(y0, y1); w.y = cvtpk(y2, y3);
                *(u32x2*)(mixed + row * DMIX + DATT + pc) = w;
            }
            if (h < 2) {
#pragma unroll
                for (int pti = 0; pti < 2; ++pti)
#pragma unroll
                    for (int ks = 0; ks < 4; ++ks) hpc[pti][ks] = hpn[pti][ks];
            }
        }
    }
    ssq += __shfl_xor(ssq, 16); ssq += __shfl_xor(ssq, 32);
    if (fq == 0) ssl[ph * 64 + 16 * rt + fr] = ssq;
    __syncthreads();
    {
        const float tot = ssl[16 * rt + fr] + ssl[64 + 16 * rt + fr];
        const float inv = rsqrtf(tot * (1.0f / DINNER) + EPS);
        const float* __restrict__ gs = P.in[I_NSSD];
#pragma unroll
        for (int hh = 0; hh < 2; ++hh) {
            u32x2 rv[6][2]; f32x4 gv[6][2];
#pragma unroll
            for (int k = 0; k < 6; ++k)
#pragma unroll
                for (int pti = 0; pti < 2; ++pti) {
                    const int pc = (hh * 6 + k) * 64 + (2 * ph + pti) * 16 + fq * 4;
                    rv[k][pti] = *(const u32x2*)(mixed + row * DMIX + DATT + pc); gv[k][pti] = *(const f32x4*)(gs + pc);
                }
#pragma unroll
            for (int k = 0; k < 6; ++k)
#pragma unroll
                for (int pti = 0; pti < 2; ++pti) {
                    const int pc = (hh * 6 + k) * 64 + (2 * ph + pti) * 16 + fq * 4;
                    const u32x2 v = rv[k][pti]; const f32x4 g4 = gv[k][pti];
                    u32x2 w; w.x = cvtpk(bflo(v.x) * inv * g4.x, bfhi(v.x) * inv * g4.y); w.y = cvtpk(bflo(v.y) * inv * g4.z, bfhi(v.y) * inv * g4.w);
                    *(u32x2*)(mixed + row * DMIX + DATT + pc) = w;
                }
        }
    }
    if (do_alpha) alpha_rows(mixed, LSE, (size_t)b * SEQ + c * 128 + 64 * hf, tid);
}

__device__ __forceinline__ void p6_final(const Params& P, int wave, int lane, int G) {
    const float* SS2 = (const float*)(P.ws + WS_SS2); const float* gf = P.in[I_NFIN];
    const int gw = blockIdx.x * 8 + wave, NGW = G * 8;
    f32x4 gv[4];
#pragma unroll
    for (int j = 0; j < 4; ++j) gv[j] = ((const f32x4*)gf)[lane + 64 * j];
    f32x4 nv[4]; float ns = 0.f;
    if (gw < M) { ns = SS2[gw];
#pragma unroll
        for (int j = 0; j < 4; ++j) nv[j] = __builtin_nontemporal_load((const f32x4*)(P.out + (size_t)gw * DM) + lane + 64 * j); }
#pragma unroll 1
    for (int row = gw; row < M; row += NGW) {
        f32x4 v[4]; const float s2 = ns;
#pragma unroll
        for (int j = 0; j < 4; ++j) v[j] = nv[j];
        const int nr = row + NGW;
        if (nr < M) { ns = SS2[nr];
#pragma unroll
            for (int j = 0; j < 4; ++j) nv[j] = __builtin_nontemporal_load((const f32x4*)(P.out + (size_t)nr * DM) + lane + 64 * j); }
        const float inv = rsqrtf(s2 * (1.0f / DM) + EPS);
        f32x4* yr = (f32x4*)(P.out + (size_t)row * DM);
#pragma unroll
        for (int j = 0; j < 4; ++j) __builtin_nontemporal_store(v[j] * inv * gv[j], yr + lane + 64 * j);
    }
}

#define XB_TMO      128
#define XB_XCNT(j)  (256  + 64 * (j))
#define XB_XSUB(j)  (1280 + 64 * (j))
#define XB_XGEN(j)  (2304 + 64 * (j))
#define XB_TOP      3328
#define XB_TOPGEN   3392
#define XCD_BAR_WORDS 3456
#define XB_SPIN_CAP (1u << 18)

__device__ __forceinline__ unsigned xb_ld(unsigned* p)              { return __hip_atomic_load(p, __ATOMIC_RELAXED, __HIP_MEMORY_SCOPE_AGENT); }
__device__ __forceinline__ unsigned xb_add(unsigned* p, unsigned v) { return __hip_atomic_fetch_add(p, v, __ATOMIC_RELAXED, __HIP_MEMORY_SCOPE_AGENT); }
__device__ __forceinline__ unsigned xb_xcc_id() { return (unsigned)__builtin_amdgcn_s_getreg((3 << 11) | 20) & 0xFu; }
#define XB_SPIN(cond, bar) do { unsigned _sp = 0; while (cond) { __builtin_amdgcn_s_sleep(1); \
    if ((++_sp & 255u) == 0u) { if (xb_ld(&(bar)[XB_TMO])) break; if (_sp > XB_SPIN_CAP) { atomicAdd(&(bar)[XB_TMO], 1u); break; } } } } while (0)

struct XcdBarrier {
    unsigned* bar; unsigned x;
    volatile LAS unsigned* st;
};

__device__ __forceinline__ XcdBarrier xcd_barrier_post(unsigned* bar, volatile LAS unsigned* st) {
    XcdBarrier b; b.bar = bar; b.x = xb_xcc_id(); b.st = st;
    if (threadIdx.x == 0) (void)xb_add(&bar[XB_XCNT(b.x)], 1u);
    return b;
}
__device__ __forceinline__ void xcd_barrier_complete(unsigned* bar, unsigned x, unsigned& nloc, unsigned& nx) {
    const unsigned G = gridDim.x * gridDim.y * gridDim.z;
    unsigned sum, cnt, mine, sp = 0u;
    for (;;) {
        sum = 0u; cnt = 0u; mine = 0u;
#pragma unroll
        for (unsigned j = 0; j < 16; ++j) { const unsigned c = xb_ld(&bar[XB_XCNT(j)]); sum += c; cnt += (c > 0u) ? 1u : 0u; mine = (j == x) ? c : mine; }
        if (sum == G) break;
        __builtin_amdgcn_s_sleep(1);
        if ((++sp & 255u) == 0u) { if (xb_ld(&bar[XB_TMO])) break; if (sp > XB_SPIN_CAP) { atomicAdd(&bar[XB_TMO], 1u); break; } }
    }
    nloc = mine > 0u ? mine : 1u; nx = cnt > 0u ? cnt : 1u;
}

__device__ __forceinline__ void xcd_barrier(const XcdBarrier& b) {
    asm volatile("s_waitcnt vmcnt(0)" ::: "memory");
    __syncthreads();
    if (threadIdx.x == 0) {
        unsigned* bar = b.bar;
        __builtin_amdgcn_s_waitcnt(0);
        unsigned nloc = b.st[0], nx = b.st[1];
        if (nloc == 0u) { xcd_barrier_complete(bar, b.x, nloc, nx); b.st[0] = nloc; b.st[1] = nx; }
        const unsigned old = xb_add(&bar[XB_XSUB(b.x)], 1u);
        const unsigned gen = old / nloc;
        if (old + 1u == (gen + 1u) * nloc) {
            __builtin_amdgcn_fence(__ATOMIC_RELEASE, "agent");
            asm volatile("s_waitcnt vmcnt(0)" ::: "memory");
            const unsigned og = xb_add(&bar[XB_TOP], 1u);
            const unsigned tg = og / nx;
            if (og + 1u == (tg + 1u) * nx) xb_add(&bar[XB_TOPGEN], 1u);
            else XB_SPIN(xb_ld(&bar[XB_TOPGEN]) == tg, bar);
            __builtin_amdgcn_fence(__ATOMIC_ACQUIRE, "agent");
            xb_add(&bar[XB_XGEN(b.x)], 1u);
            asm volatile("s_waitcnt vmcnt(0)" ::: "memory");
        } else {
            XB_SPIN(xb_ld(&bar[XB_XGEN(b.x)]) == gen, bar);
            __builtin_amdgcn_fence(__ATOMIC_ACQUIRE, "agent");
            asm volatile("s_waitcnt vmcnt(0)" ::: "memory");
        }
    }
    __syncthreads();
}

#ifndef MK_ONE_LAUNCH
#define MK_ONE_LAUNCH 1
#endif
constexpr int GG = 132;
#ifndef NC_ACT
#define NC_ACT 124
#endif
__device__ __forceinline__ void filler(const Params& P, LAS unsigned char* lds, int tid, int ph, bool drain) {
    unsigned* ctl = (unsigned*)(P.ws + WS_CTL);
    unsigned* head = ctl + 4160; unsigned* done = ctl + 4224 + 64 * ph;
    LAS int* wq = (LAS int*)(lds + BAR_LDS_OFF + 64);
    __syncthreads();
    const bool gemm_wg = (int)blockIdx.x < GG;
    if (tid == 0 && gemm_wg) __hip_atomic_fetch_add(done, 1u, __ATOMIC_RELAXED, __HIP_MEMORY_SCOPE_AGENT);
    if (gemm_wg && !drain) return;
    unsigned nxt = (unsigned)NCOPY, dn = 0u;
    if (tid == 0) nxt = __hip_atomic_fetch_add(head, 1u, __ATOMIC_RELAXED, __HIP_MEMORY_SCOPE_AGENT);
    for (;;) {
        if (tid == 0) wq[0] = nxt < (unsigned)NCOPY ? (int)nxt : -1;
        __syncthreads();
        const int ci = wq[0];
        __syncthreads();
        if (ci < 0) break;
        if (tid == 0) {
            if (drain || dn < (unsigned)GG) { nxt = __hip_atomic_fetch_add(head, 1u, __ATOMIC_RELAXED, __HIP_MEMORY_SCOPE_AGENT); dn = __hip_atomic_load(done, __ATOMIC_RELAXED, __HIP_MEMORY_SCOPE_AGENT); }
            else nxt = (unsigned)NCOPY;
        }
        const CopyDesc d = copy_desc(ci, P);
        f32x4 v[16];
#pragma unroll
        for (int i = 0; i < 16; ++i) { const int idx = tid + 512 * i; if (idx < d.n4) v[i] = __builtin_nontemporal_load(d.src + idx); }
#pragma unroll
        for (int i = 0; i < 16; ++i) { const int idx = tid + 512 * i; if (idx < d.n4) __builtin_nontemporal_store(v[i], d.dst + idx); }
    }
}
#ifndef GREP
#define GREP 1
#endif
struct RepOrder {
    pg8::StaticOrder b; int nc;
    __device__ __forceinline__ void init(int M_, int N_, int G_, int c_) { b.init(M_, N_, G_, c_); nc = c_ < b.nwg ? (b.nwg - c_ + G_ - 1) / G_ : 0; }
    __device__ __forceinline__ bool next(int i, pg8::Unit& u) const { if (i >= nc * GREP) return false; return b.next(i % nc, u); }
    __device__ __forceinline__ void a_ready(const pg8::Unit&) const {}
    __device__ __forceinline__ void done(const pg8::Unit&) const {}
};
constexpr int N_PHASES = 9;
#ifndef FILL_MASK
#define FILL_MASK 0xA0
#endif
constexpr int NCOPY3 = 1900;
struct Args { Params P; int ph_lo, ph_hi; };
static_assert(sizeof(Args) == 22 * 8 + 8, "no padding in Args");

__global__ void __launch_bounds__(512, 2) hybrid_fwd(Args args) {
    extern __shared__ __attribute__((aligned(16))) unsigned char lds_raw[];
    LAS unsigned char* lds = (LAS unsigned char*)lds_raw;
    const Params& P = args.P;
    const int tid = threadIdx.x, lane = tid & 63, wave = __builtin_amdgcn_readfirstlane(tid >> 6), G = gridDim.x;
    unsigned char* ws = P.ws;
    const int lo = args.ph_lo, hi = args.ph_hi;
    if (lo > 1000) cg::this_grid().sync();
    if (tid < 2) ((LAS unsigned*)(lds + BAR_LDS_OFF))[tid] = 0u;
    __syncthreads();
    (void)xcd_barrier_post((unsigned*)(ws + WS_CTL), (volatile LAS unsigned*)(lds + BAR_LDS_OFF));
#define IN(k) (lo <= (k) && (k) < hi)
#define FILL(k) do { if ((FILL_MASK >> (k)) & 1) filler(P, lds, tid, (k), (k) == 7); } while (0)
#define SEAM(k) do { if (IN(k) && IN((k) + 1)) { XcdBarrier bb; bb.bar = (unsigned*)(args.P.ws + WS_CTL); bb.x = xb_xcc_id(); bb.st = (volatile LAS unsigned*)(lds + BAR_LDS_OFF); xcd_barrier(bb); } } while (0)
    if (IN(0)) { p0_prologue(P, lds, tid, wave, lane, G); }
    SEAM(0);
    if (IN(1)) {
        pg8::Gemm g{(const pg8::bf16_t*)(ws + WS_XN), (const pg8::bf16_t*)(ws + WS_WIN), M, NIN, DM}; RepOrder S; S.init(M, NIN, G, (int)blockIdx.x);
        EpiIn E{(bf16*)(ws + WS_Q), (bf16*)(ws + WS_K), (bf16*)(ws + WS_V), (bf16*)(ws + WS_Z), (bf16*)(ws + WS_XBC), (float*)(ws + WS_QS), P.out};
        pg8::gemm_phase<EpiIn, RepOrder, true, true>(lds, g, S, E);
        FILL(1);
    }
    SEAM(1);
    if (IN(2)) {
        constexpr int NSA = 384, NATT = 1536, NPA = 512, NSS = 128, NCOMP = NSA + NATT + NPA + NSS;
        unsigned* ctr = (unsigned*)(ws + WS_CTL) + 4096;
        LAS int* wq = (LAS int*)(lds + BAR_LDS_OFF + 64);
        unsigned nxt = 0u;
        if (tid == 0) nxt = atomicAdd(ctr, 1u);
        for (;;) {
            __syncthreads();
            if (tid == 0) *wq = (int)nxt;
            __syncthreads();
            int r = *wq;
            if (r >= NCOMP) break;
            if (tid == 0) nxt = atomicAdd(ctr, 1u);
            int t_ = tid; asm volatile("" : "+v"(t_));
            const int l_ = t_ & 63, w_ = __builtin_amdgcn_readfirstlane(t_ >> 6);
            if (r < NSS) { ssd_sample_item(lds, r, P, t_, w_, l_); continue; } r -= NSS;
            if (r < NSA) { attn_sample_item(lds, r, P, t_, w_, l_); continue; } r -= NSA;
            if (r < NPA) { ssd_passA_item(lds, r, P, t_, w_, l_); continue; } r -= NPA;
            attn_item(lds, r, (const bf16*)(ws + WS_Q), (const bf16*)(ws + WS_K), (const bf16*)(ws + WS_V), (bf16*)(ws + WS_MIX), (float*)(ws + WS_LSE), t_, w_, l_);
        }
        FILL(2);
    }
    SEAM(2);
    if (IN(3)) { p2b_scan(P, tid, G); }
    SEAM(3);
    if (IN(4)) {
        for (int it = blockIdx.x; it < NB * NCH * 2 + MS / 64; it += G) {
            if (it < NB * NCH * 2) p2c_item(lds, it, P, tid, wave, lane);
            else alpha_rows((bf16*)(ws + WS_MIX), (const float*)(ws + WS_LSE), (size_t)MP + (it - NB * NCH * 2) * 64, tid);
        }
        FILL(4);
    }
    SEAM(4);
    if (IN(5)) {
        if ((int)blockIdx.x < GG) {
            pg8::Gemm g{(const pg8::bf16_t*)(ws + WS_MIX), (const pg8::bf16_t*)(ws + WS_WO), M, DM, DMIX}; pg8::StaticOrder S; S.init(M, DM, GG, (int)blockIdx.x);
            EpiOut E{P.in[I_XP], P.in[I_XS], P.in[I_NFFN], (float*)(ws + WS_H), (bf16*)(ws + WS_XN), (float*)(ws + WS_SS1)};
            pg8::gemm_phase<EpiOut, pg8::StaticOrder, true, true>(lds, g, S, E);
        }
        FILL(5);
    }
    SEAM(5);
    if (IN(6)) {
        pg8::Gemm g{(const pg8::bf16_t*)(ws + WS_XN), (const pg8::bf16_t*)(ws + WS_WGU), M, NGU, DM}; RepOrder S; S.init(M, NGU, G, (int)blockIdx.x);
        EpiGU E{(const float*)(ws + WS_SS1), (bf16*)(ws + WS_ACT)};
        pg8::gemm_phase<EpiGU, RepOrder, true, true>(lds, g, S, E);
        FILL(6);
    }
    SEAM(6);
    if (IN(7)) {
        if ((int)blockIdx.x < GG) {
            pg8::Gemm g{(const pg8::bf16_t*)(ws + WS_ACT), (const pg8::bf16_t*)(ws + WS_WD), M, DM, DFF}; pg8::StaticOrder S; S.init(M, DM, GG, (int)blockIdx.x);
            EpiDown E{(const float*)(ws + WS_H), P.out, (float*)(ws + WS_SS2)};
            pg8::gemm_phase<EpiDown, pg8::StaticOrder, true, true>(lds, g, S, E);
        }
        FILL(7);
    }
    SEAM(7);
    if (IN(8)) { p6_final(P, wave, lane, G); }
#undef IN
#undef FILL
#undef SEAM
}

extern "C" void kernel_launch(void* const* d_in, const int* in_sizes, int n_in, void* d_out, int out_size, void* d_ws, size_t ws_size, hipStream_t stream) {
    static int grid = 0;
    if (grid == 0) {
        if (n_in != 20 || (size_t)out_size != O_END || ws_size < WS_END) { fprintf(stderr, "kernel_launch: unexpected shapes: n_in %d out %d ws %zu (need %zu)\n", n_in, out_size, ws_size, (size_t)WS_END); grid = -1; return; }
        int dev = 0, cus = 0, per_cu = 0;
        (void)hipGetDevice(&dev); (void)hipDeviceGetAttribute(&cus, hipDeviceAttributeMultiprocessorCount, dev);
        if (hipFuncSetAttribute((const void*)hybrid_fwd, hipFuncAttributeMaxDynamicSharedMemorySize, LDS_BYTES) != hipSuccess) { fprintf(stderr, "kernel_launch: hipFuncSetAttribute failed\n"); grid = -1; return; }
        if (hipOccupancyMaxActiveBlocksPerMultiprocessor(&per_cu, (const void*)hybrid_fwd, 512, LDS_BYTES) != hipSuccess || per_cu < 1) { fprintf(stderr, "kernel_launch: occupancy query says %d\n", per_cu); per_cu = 1; }
        (void)hipGetLastError();
        grid = cus > 0 ? cus : 256;
    }
    if (grid < 0) return;
    (void)hipMemsetAsync((char*)d_ws + WS_CTL, 0, CTL_BYTES, stream);
    Args a{};
    for (int i = 0; i < 20; ++i) a.P.in[i] = (const float*)d_in[i];
    a.P.out = (float*)d_out; a.P.ws = (unsigned char*)d_ws;
#if MK_ONE_LAUNCH
    a.ph_lo = 0; a.ph_hi = N_PHASES;
    void* kargs[] = {&a};
    hipError_t e = hipLaunchCooperativeKernel((const void*)hybrid_fwd, dim3(grid), dim3(512), kargs, LDS_BYTES, stream);
    if (e != hipSuccess) fprintf(stderr, "kernel_launch: cooperative launch failed: %s (grid %d)\n", hipGetErrorString(e), grid);
#else
    for (int ph = 0; ph < N_PHASES; ++ph) {
        a.ph_lo = ph; a.ph_hi = ph + 1;
        hipLaunchKernelGGL(hybrid_fwd, dim3(grid), dim3(512), LDS_BYTES, stream, a);
    }
#endif
}
```

```cpp
#include <hip/hip_runtime.h>
#include <hip/hip_cooperative_groups.h>
#include <cstdio>
#include <cstdint>
namespace cg = cooperative_groups;
namespace pg8 {
#define PG8_LAS __attribute__((address_space(3)))
typedef unsigned short bf16_t;
typedef short bf16x8 __attribute__((ext_vector_type(8)));
typedef float f32x4 __attribute__((ext_vector_type(4)));
typedef unsigned u32x4 __attribute__((ext_vector_type(4)));
constexpr int BM = 256, BK = 64, HALF = 128, HTB = HALF * BK * 2  , STAGE_BYTES = 8 * HTB, NXCD = 8, WGM = 8;

__host__ __device__ __forceinline__ int lds_byte(int r, int c) { const int st = (r >> 4) * 2 + (c >> 5), rr = r & 15, cc = c & 31, ob = rr * 64 + cc * 2; return st * 1024 + (ob ^ (((ob >> 9) & 1) << 5)); }
__host__ __device__ __forceinline__ void stage_rc(int b, int& R, int& C) { const int st = b / 1024, sb = b % 1024, swz = sb ^ (((sb >> 9) & 1) << 5); R = (st >> 1) * 16 + swz / 64; C = (st & 1) * 32 + (swz % 64) / 2; }
__host__ __device__ __forceinline__ int perm32(int rho) { const int n = rho >> 4, i = rho & 15; return 8 * (i >> 2) + 4 * n + (i & 3); }

struct Unit { int pm, pn; };
struct Gemm { const bf16_t* A; const bf16_t* Bt; int M, N, K; };

struct StaticOrder {
    int nM, nN, nwg, G, c;
    __host__ __device__ __forceinline__ void init(int M, int N, int G_, int c_) { nM = M / BM; nN = N / BM; nwg = nM * nN; G = G_; c = c_; }
    __host__ __device__ __forceinline__ bool next(int i, Unit& u) const {
        const long L = (long)i * G + c; if (L >= nwg) return false;
        int wgid = (int)L; { const int q = nwg / NXCD, r = nwg % NXCD, xcd = wgid % NXCD, off = wgid / NXCD; wgid = (xcd < r ? xcd * (q + 1) : r * (q + 1) + (xcd - r) * q) + off; }
        const int nig = WGM * nN, gid = wgid / nig, fm = gid * WGM, gsz = (nM - fm) < WGM ? (nM - fm) : WGM;
        u.pm = fm + ((wgid % nig) % gsz); u.pn = (wgid % nig) / gsz; return true;
    }
    __device__ __forceinline__ void a_ready(const Unit&) const {}
    __device__ __forceinline__ void done(const Unit&) const {}
};

__device__ __forceinline__ unsigned cvt_pk_bf16(float lo, float hi) { unsigned r; asm volatile("v_cvt_pk_bf16_f32 %0, %1, %2" : "=v"(r) : "v"(lo), "v"(hi)); return r; }
template <class Epi, class Sched, bool ALIGN_EPI = false, bool SP2 = false>
__device__ __forceinline__ void gemm_phase(PG8_LAS unsigned char* lds, const Gemm g, const Sched& S, const Epi& E) {
    int tid_ = threadIdx.x; asm volatile("" : "+v"(tid_));
    const int tid = tid_, wid = __builtin_amdgcn_readfirstlane(tid >> 6), lane = tid & 63, wr = wid >> 2, wc = wid & 3, fr = lane & 15, fq = lane >> 4;
    const int K = g.K, nt = K / BK;
    unsigned voffA[2], voffB[2];
#pragma unroll
    for (int i = 0; i < 2; ++i) { int R, C; stage_rc(tid * 16 + i * 8192, R, C); const int Rb = Epi::PERM ? ((R & ~31) + perm32(R & 31)) : R;
        voffA[i] = (unsigned)(R * K + C) * 2u; voffB[i] = (unsigned)(Rb * K + C) * 2u; }
    const size_t kstep = (size_t)(BK * 2);
    const size_t hstep = (size_t)HALF * K * 2;
    const size_t tstep = 2 * hstep;
    const unsigned ldsw = (unsigned)wid * 1024u;
    const int aoff = lds_byte(wr * 64 + fr, fq * 8), boff = lds_byte(wc * 32 + fr, fq * 8);
#define PG8_SA(b, h) (((b) * 2 + (h)) * HTB)
#define PG8_SB(b, h) ((4 + (b) * 2 + (h)) * HTB)
#define PG8_STAGE(bufoff, gbase, voff) do { _Pragma("unroll") for (int _i = 0; _i < 2; ++_i) \
        __builtin_amdgcn_global_load_lds((const unsigned*)((const char*)(gbase) + (voff)[_i]), (PG8_LAS unsigned*)(lds + (bufoff) + ldsw + _i * 8192), 16, 0, 0); } while (0)
#define PG8_LDA(dst, b, h) do { _Pragma("unroll") for (int m = 0; m < 4; ++m) _Pragma("unroll") for (int k = 0; k < 2; ++k) dst[m][k] = *(const PG8_LAS bf16x8*)(lds + PG8_SA(b, h) + aoff + m * 2048 + k * 1024); } while (0)
#define PG8_LDB(dst, b, h) do { _Pragma("unroll") for (int n = 0; n < 2; ++n) _Pragma("unroll") for (int k = 0; k < 2; ++k) dst[n][k] = *(const PG8_LAS bf16x8*)(lds + PG8_SB(b, h) + boff + n * 2048 + k * 1024); } while (0)
#define PG8_MMA(ai, bj, At, Bt) do { __builtin_amdgcn_s_setprio(1); _Pragma("unroll") for (int m = 0; m < 4; ++m) _Pragma("unroll") for (int n = 0; n < 2; ++n) _Pragma("unroll") for (int k = 0; k < 2; ++k) \
        acc[ai][bj][m][n] = __builtin_amdgcn_mfma_f32_16x16x32_bf16(Bt[n][k], At[m][k], acc[ai][bj][m][n], 0, 0, 0); __builtin_amdgcn_s_setprio(0); } while (0)
#define PG8_WAIT_V(n) asm volatile("s_waitcnt vmcnt(" #n ")" ::: "memory")
#define PG8_WAIT_L(n) asm volatile("s_waitcnt lgkmcnt(" #n ")" ::: "memory")
#define PG8_BAR __builtin_amdgcn_s_barrier()
#define PG8_SCHED __builtin_amdgcn_sched_barrier(0)
    Unit cur, nxt; int ui = 0;
    if (!S.next(0, cur)) return;
    f32x4 acc[2][2][4][2];
#pragma unroll
    for (int a = 0; a < 2; ++a)
#pragma unroll
        for (int b = 0; b < 2; ++b)
#pragma unroll
            for (int m = 0; m < 4; ++m)
#pragma unroll
                for (int n = 0; n < 2; ++n) acc[a][b][m][n] = (f32x4){0.f, 0.f, 0.f, 0.f};
    bf16x8 At[4][2], B0[2][2], B1[2][2];
    const char* cA = (const char*)g.A + (size_t)cur.pm * tstep; const char* cB = (const char*)g.Bt + (size_t)cur.pn * tstep;
    S.a_ready(cur);
    if constexpr (SP2) {
        PG8_STAGE(PG8_SB(0, 0), cB, voffB); PG8_STAGE(PG8_SB(0, 1), cB + hstep, voffB); PG8_STAGE(PG8_SA(0, 0), cA, voffA); PG8_STAGE(PG8_SA(0, 1), cA + hstep, voffA);
        if (wr == 1) PG8_BAR;
        PG8_WAIT_V(2); PG8_BAR;
        PG8_STAGE(PG8_SB(1, 0), cB + kstep, voffB); PG8_STAGE(PG8_SA(1, 0), cA + kstep, voffA); PG8_STAGE(PG8_SB(1, 1), cB + hstep + kstep, voffB);
        PG8_WAIT_V(6); PG8_BAR;
    } else {
        PG8_STAGE(PG8_SB(0, 0), cB, voffB); PG8_STAGE(PG8_SA(0, 0), cA, voffA); PG8_STAGE(PG8_SB(0, 1), cB + hstep, voffB); PG8_STAGE(PG8_SA(0, 1), cA + hstep, voffA);
        if (wr == 1) PG8_BAR;
        PG8_WAIT_V(4); PG8_BAR;
        PG8_STAGE(PG8_SB(1, 0), cB + kstep, voffB); PG8_STAGE(PG8_SA(1, 0), cA + kstep, voffA); PG8_STAGE(PG8_SB(1, 1), cB + hstep + kstep, voffB);
        PG8_WAIT_V(6); PG8_BAR;
    }
    for (;;) {
        const bool has_next = S.next(ui + 1, nxt);
        const char* nA = has_next ? (const char*)g.A + (size_t)nxt.pm * tstep : cA; const char* nB = has_next ? (const char*)g.Bt + (size_t)nxt.pn * tstep : cB;
        for (int t = 0; t < nt; t += 2) {
            const bool last = (t == nt - 2);
            const char* a1 = cA + (size_t)(t + 1) * kstep;
            const char* a2 = last ? nA : cA + (size_t)(t + 2) * kstep; const char* b2 = last ? nB : cB + (size_t)(t + 2) * kstep;
            const char* a3 = a2 + kstep; const char* b3 = b2 + kstep;
            if (last && has_next) S.a_ready(nxt);
            if constexpr (SP2) {
            PG8_LDB(B0, 0, 0); PG8_LDB(B1, 0, 1); PG8_SCHED; PG8_LDA(At, 0, 0); PG8_STAGE(PG8_SA(1, 1), a1 + hstep, voffA);
            PG8_WAIT_V(8); PG8_WAIT_L(0); PG8_BAR; PG8_MMA(0, 0, At, B0); PG8_MMA(0, 1, At, B1); PG8_BAR; PG8_SCHED;
            PG8_LDA(At, 0, 1); PG8_STAGE(PG8_SB(0, 0), b2, voffB); PG8_STAGE(PG8_SB(0, 1), b2 + hstep, voffB); PG8_STAGE(PG8_SA(0, 0), a2, voffA);
            PG8_WAIT_V(8); PG8_WAIT_L(0); PG8_BAR; PG8_MMA(1, 0, At, B0); PG8_MMA(1, 1, At, B1); PG8_BAR; PG8_SCHED;
            PG8_LDB(B0, 1, 0); PG8_LDB(B1, 1, 1); PG8_SCHED; PG8_LDA(At, 1, 0); PG8_STAGE(PG8_SA(0, 1), a2 + hstep, voffA);
            PG8_WAIT_V(8); PG8_WAIT_L(0); PG8_BAR; PG8_MMA(0, 0, At, B0); PG8_MMA(0, 1, At, B1); PG8_BAR; PG8_SCHED;
            PG8_LDA(At, 1, 1); PG8_STAGE(PG8_SB(1, 0), b3, voffB); PG8_STAGE(PG8_SB(1, 1), b3 + hstep, voffB); PG8_STAGE(PG8_SA(1, 0), a3, voffA);
            PG8_WAIT_V(8); PG8_WAIT_L(0); PG8_BAR; PG8_MMA(1, 0, At, B0); PG8_MMA(1, 1, At, B1); PG8_BAR; PG8_SCHED;
            } else {
            PG8_LDB(B0, 0, 0); PG8_SCHED; PG8_LDA(At, 0, 0); PG8_STAGE(PG8_SA(1, 1), a1 + hstep, voffA);
            PG8_WAIT_L(8); PG8_BAR; PG8_WAIT_L(0); PG8_MMA(0, 0, At, B0); PG8_BAR; PG8_SCHED;
            PG8_LDB(B1, 0, 1); PG8_STAGE(PG8_SB(0, 0), b2, voffB);
            PG8_BAR; PG8_WAIT_L(0); PG8_MMA(0, 1, At, B1); PG8_BAR;
            PG8_LDA(At, 0, 1); PG8_STAGE(PG8_SA(0, 0), a2, voffA);
            PG8_BAR; PG8_WAIT_L(0); PG8_MMA(1, 0, At, B0); PG8_BAR; PG8_SCHED;
            PG8_STAGE(PG8_SB(0, 1), b2 + hstep, voffB);
            PG8_WAIT_V(6); PG8_BAR; PG8_MMA(1, 1, At, B1); PG8_BAR;
            PG8_LDB(B0, 1, 0); PG8_SCHED; PG8_LDA(At, 1, 0); PG8_STAGE(PG8_SA(0, 1), a2 + hstep, voffA);
            PG8_WAIT_L(8); PG8_BAR; PG8_WAIT_L(0); PG8_MMA(0, 0, At, B0); PG8_BAR; PG8_SCHED;
            PG8_LDB(B1, 1, 1); PG8_STAGE(PG8_SB(1, 0), b3, voffB);
            PG8_BAR; PG8_WAIT_L(0); PG8_MMA(0, 1, At, B1); PG8_BAR;
            PG8_LDA(At, 1, 1); PG8_STAGE(PG8_SA(1, 0), a3, voffA);
            PG8_BAR; PG8_WAIT_L(0); PG8_MMA(1, 0, At, B0); PG8_BAR; PG8_SCHED;
            PG8_STAGE(PG8_SB(1, 1), b3 + hstep, voffB);
            PG8_WAIT_V(6); PG8_BAR; PG8_MMA(1, 1, At, B1); PG8_BAR;
            }
        }
        if constexpr (ALIGN_EPI) { if (wr == 0) PG8_BAR; }
        if constexpr (!Epi::AFTER_DRAIN) { E(acc, cur, wr, wc, fr, fq); S.done(cur); }
        if (!has_next) break;
#pragma unroll
        for (int a = 0; a < 2; ++a)
#pragma unroll
            for (int b = 0; b < 2; ++b)
#pragma unroll
                for (int m = 0; m < 4; ++m)
#pragma unroll
                    for (int n = 0; n < 2; ++n) acc[a][b][m][n] = (f32x4){0.f, 0.f, 0.f, 0.f};
        cur = nxt; cA = nA; cB = nB; ++ui;
        if constexpr (ALIGN_EPI) { if (wr == 1) PG8_BAR; }
    }
    PG8_WAIT_V(0);
    if constexpr (!ALIGN_EPI) { if (wr == 0) PG8_BAR; }
    PG8_BAR;
    if constexpr (Epi::AFTER_DRAIN) { E.fused(acc, cur, wr, wc, fr, fq, lds, wid, lane); S.done(cur); }
#undef PG8_SA
#undef PG8_SB
#undef PG8_STAGE
#undef PG8_LDA
#undef PG8_LDB
#undef PG8_MMA
#undef PG8_WAIT_V
#undef PG8_WAIT_L
#undef PG8_BAR
#undef PG8_SCHED
}
}

#define LAS __attribute__((address_space(3)))
typedef unsigned short bf16;
typedef float f32x4 __attribute__((ext_vector_type(4)));
typedef short bf16x8 __attribute__((ext_vector_type(8)));
typedef unsigned u32x4 __attribute__((ext_vector_type(4)));
typedef unsigned u32x2 __attribute__((ext_vector_type(2)));

constexpr int DM = 1024, NB = 4, SEQ = 4096, MP = NB * SEQ, DB = 128, DSQ = 4, MS = DB * DSQ, M = MP + MS;
constexpr int DATT = 768, DINNER = 768, CONVD = 1792, NIN = 4864, NINTOT = 4876, DMIX = 1536, DFF = 2816, NGU = 5632;
constexpr int NH = 12, NCH = 32;
constexpr float EPS = 1e-5f, ATT_SCALE = 0.125f, LOG2E = 1.4426950408889634f, LN2 = 0.6931471805599453f;

constexpr size_t O_YP = 0, O_YS = O_YP + (size_t)MP * DM, O_PKV1 = O_YS + (size_t)MS * DM, O_PKV4 = O_PKV1 + (size_t)NB * 128 * 512, O_PKV16 = O_PKV4 + (size_t)NB * 512 * 512,
                 O_PCONV = O_PKV16 + (size_t)NB * 2048 * 512, O_PSSM = O_PCONV + (size_t)NB * 3 * CONVD, O_SKV1 = O_PSSM + (size_t)NB * NH * 64 * 128, O_SKV4 = O_SKV1 + (size_t)DB * 128 * 512,
                 O_SKV16 = O_SKV4 + (size_t)DB * 512 * 512, O_SCONV = O_SKV16 + (size_t)DB * 2048 * 512, O_SSSM = O_SCONV + (size_t)DB * 3 * CONVD, O_END = O_SSSM + (size_t)DB * NH * 64 * 128;
static_assert(O_YS == (size_t)MP * DM, "y rows contiguous");

constexpr size_t al256(size_t x) { return (x + 255) & ~(size_t)255; }
constexpr size_t WS_CTL = 0, CTL_BYTES = 65536;
constexpr size_t WS_WIN = CTL_BYTES;
constexpr size_t WS_WO = al256(WS_WIN + (size_t)NIN * DM * 2);
constexpr size_t WS_WGU = al256(WS_WO + (size_t)DM * DMIX * 2);
constexpr size_t WS_WD = al256(WS_WGU + (size_t)NGU * DM * 2);
constexpr size_t WS_XN = al256(WS_WD + (size_t)DM * DFF * 2);
constexpr size_t WS_DT = al256(WS_XN + (size_t)M * DM * 2);
constexpr size_t WS_Q = al256(WS_DT + (size_t)M * 12 * 4);
constexpr size_t WS_K = al256(WS_Q + (size_t)NB * 12 * SEQ * 64 * 2);
constexpr size_t WS_V = al256(WS_K + (size_t)NB * 12 * SEQ * 64 * 2);
constexpr size_t WS_QS = al256(WS_V + (size_t)NB * 12 * SEQ * 64 * 2);
constexpr size_t WS_Z = al256(WS_QS + (size_t)MS * DATT * 4);
constexpr size_t WS_XBC = al256(WS_Z + (size_t)M * DINNER * 2);
constexpr size_t WS_MIX = al256(WS_XBC + (size_t)M * CONVD * 2);
constexpr size_t WS_LSE = al256(WS_MIX + (size_t)M * DMIX * 2);
constexpr size_t WS_SLOC = al256(WS_LSE + (size_t)M * 12 * 4);
constexpr size_t WS_HPREV = al256(WS_SLOC + (size_t)NB * NCH * NH * 64 * 128 * 4);
constexpr size_t WS_CD = al256(WS_HPREV + (size_t)NB * NCH * NH * 64 * 128 * 2);
constexpr size_t WS_H = al256(WS_CD + (size_t)NB * NCH * NH * 4);
constexpr size_t WS_ACT = al256(WS_H + (size_t)M * DM * 4);
constexpr size_t WS_SS1 = al256(WS_ACT + (size_t)M * DFF * 2);
constexpr size_t WS_SS2 = al256(WS_SS1 + (size_t)M * 4);
constexpr size_t WS_XC = al256(WS_SS2 + (size_t)M * 4);
constexpr size_t WS_END = al256(WS_XC + (size_t)MP * CONVD * 2);

constexpr int BAR_LDS_OFF = 139264;
constexpr int LDS_BYTES = 147456;

typedef float f32x2_t __attribute__((ext_vector_type(2)));
typedef __bf16 bf16x2_t __attribute__((ext_vector_type(2)));
__device__ __forceinline__ unsigned cvtpk(float lo, float hi) { f32x2_t v = {lo, hi}; bf16x2_t b = __builtin_convertvector(v, bf16x2_t); return __builtin_bit_cast(unsigned, b); }
__device__ __forceinline__ float bflo(unsigned u) { return __uint_as_float(u << 16); }
__device__ __forceinline__ float bfhi(unsigned u) { return __uint_as_float(u & 0xffff0000u); }
__device__ __forceinline__ float bf2f(bf16 h) { return __uint_as_float((unsigned)h << 16); }
__device__ __forceinline__ float silu_f(float x) { return x / (1.0f + __expf(-x)); }
__device__ __forceinline__ float softplus_f(float x) { return x > 20.f ? x : log1pf(__expf(x)); }
__device__ __forceinline__ float wave_sum(float v) {
#pragma unroll
    for (int o = 1; o < 64; o <<= 1) v += __shfl_xor(v, o);
    return v;
}
__device__ __forceinline__ float wave_max(float v) {
#pragma unroll
    for (int o = 1; o < 64; o <<= 1) v = fmaxf(v, __shfl_xor(v, o));
    return v;
}
#define LDS_WAIT() asm volatile("s_waitcnt lgkmcnt(0)" ::: "memory")
__device__ __forceinline__ f32x4 mfma16(bf16x8 a, bf16x8 b, f32x4 c) { return __builtin_amdgcn_mfma_f32_16x16x32_bf16(a, b, c, 0, 0, 0); }
__device__ __forceinline__ bf16x8 mk8(unsigned a, unsigned b, unsigned c, unsigned d) { u32x4 v = {a, b, c, d}; return __builtin_bit_cast(bf16x8, v); }
__device__ __forceinline__ float dot4(f32x4 a, f32x4 b) { return (a.x * b.x + a.y * b.y) + (a.z * b.z + a.w * b.w); }

struct Params {
    const float* in[20];
    float* out;
    unsigned char* ws;
};
enum { I_XP = 0, I_XS, I_C1, I_C4, I_C16, I_SCONV, I_SSSM, I_NMIX, I_WIN, I_CW, I_CB, I_DTB, I_ALOG, I_DSKIP, I_NSSD, I_WOUT, I_NFFN, I_WGU, I_WD, I_NFIN };

struct EpiIn {
    static constexpr bool PERM = true, AFTER_DRAIN = false;
    bf16 *Q, *K, *V, *Z, *XBC; float* QS; float* out;
    __device__ __forceinline__ void operator()(const f32x4 (&acc)[2][2][4][2], const pg8::Unit& u, int wr, int wc, int fr, int fq) const {
        const int pn = u.pn; const bool sample = u.pm >= MP / 256;
#pragma unroll
        for (int ai = 0; ai < 2; ++ai)
#pragma unroll
            for (int m = 0; m < 4; ++m) {
                const int row = u.pm * 256 + ai * 128 + wr * 64 + m * 16 + fr;
#pragma unroll
                for (int bj = 0; bj < 2; ++bj) {
                    const int c0 = bj * 128 + wc * 32 + 8 * fq;
                    f32x4 v0 = acc[ai][bj][m][0], v1 = acc[ai][bj][m][1];
                    if (pn < 9) {
                        const int kind = pn / 3, g = pn % 3, j = c0 >> 6, d0 = c0 & 63, sh = 2 * g, win = 128 << sh;
                        if (!sample) {
                            const int b = row >> 12, t = row & 4095;
                            const int perm = (t & ((1 << sh) - 1)) * (SEQ >> sh) + (t >> sh);
                            const size_t off = ((size_t)((b * 3 + g) * 4 + j) * SEQ + perm) * 64 + d0;
                            if (kind == 0) { v0 = v0 * (ATT_SCALE * LOG2E); v1 = v1 * (ATT_SCALE * LOG2E); }
                            u32x4 w; w.x = cvtpk(v0[0], v0[1]); w.y = cvtpk(v0[2], v0[3]); w.z = cvtpk(v1[0], v1[1]); w.w = cvtpk(v1[2], v1[3]);
                            bf16* dst = kind == 0 ? Q : (kind == 1 ? K : V);
                            *(u32x4*)(dst + off) = w;
                            if (kind != 0 && t >= SEQ - win) {
                                const size_t ob = (g == 0 ? O_PKV1 : (g == 1 ? O_PKV4 : O_PKV16));
                                float* o = out + ob + ((((size_t)b * win + (t - (SEQ - win))) * 2 + (kind - 1)) * 4 + j) * 64 + d0;
                                *(f32x4*)o = acc[ai][bj][m][0]; *(f32x4*)(o + 4) = acc[ai][bj][m][1];
                            }
                        } else {
                            const int rs = row - MP, b = rs >> 2, s = rs & 3;
                            if (kind == 0) { float* o = QS + (size_t)rs * DATT + g * 256 + c0; *(f32x4*)o = v0; *(f32x4*)(o + 4) = v1; }
                            else {
                                const size_t ob = (g == 0 ? O_SKV1 : (g == 1 ? O_SKV4 : O_SKV16));
                                float* o = out + ob + ((((size_t)b * win + (win - 4 + s)) * 2 + (kind - 1)) * 4 + j) * 64 + d0;
                                *(f32x4*)o = v0; *(f32x4*)(o + 4) = v1;
                            }
                        }
                    } else {
                        u32x4 w; w.x = cvtpk(v0[0], v0[1]); w.y = cvtpk(v0[2], v0[3]); w.z = cvtpk(v1[0], v1[1]); w.w = cvtpk(v1[2], v1[3]);
                        if (pn < 12) { *(u32x4*)(Z + (size_t)row * DINNER + (pn - 9) * 256 + c0) = w; }
                        else {
                            const int col = (pn - 12) * 256 + c0;
                            *(u32x4*)(XBC + (size_t)row * CONVD + col) = w;
                            if (!sample) { const int b = row >> 12, t = row & 4095;
                                if (t >= SEQ - 3) { float* o = out + O_PCONV + ((size_t)b * 3 + (t - (SEQ - 3))) * CONVD + col; *(f32x4*)o = v0; *(f32x4*)(o + 4) = v1; } }
                            else { const int rs = row - MP, b = rs >> 2, s = rs & 3;
                                if (s >= 1) { float* o = out + O_SCONV + ((size_t)b * 3 + (s - 1)) * CONVD + col; *(f32x4*)o = v0; *(f32x4*)(o + 4) = v1; } }
                        }
                    }
                }
            }
    }
};

struct EpiOut {
    static constexpr bool PERM = false, AFTER_DRAIN = false;
    const float *xp, *xs, *gffn; float* H; bf16* HG; float* SS1;
    __device__ __forceinline__ void operator()(const f32x4 (&acc)[2][2][4][2], const pg8::Unit& u, int wr, int wc, int fr, int fq) const {
        const int colb = u.pn * 256 + wc * 32 + 4 * fq;
        f32x4 gv[2][2];
#pragma unroll
        for (int bj = 0; bj < 2; ++bj)
#pragma unroll
            for (int n = 0; n < 2; ++n) gv[bj][n] = *(const f32x4*)(gffn + colb + bj * 128 + n * 16);
#pragma unroll
        for (int ai = 0; ai < 2; ++ai) {
            f32x4 xv[4][2][2];
#pragma unroll
            for (int m = 0; m < 4; ++m) {
                const int row = u.pm * 256 + ai * 128 + wr * 64 + m * 16 + fr;
                const float* xrow = row < MP ? xp + (size_t)row * DM : xs + (size_t)(row - MP) * DM;
#pragma unroll
                for (int bj = 0; bj < 2; ++bj)
#pragma unroll
                    for (int n = 0; n < 2; ++n) xv[m][bj][n] = *(const f32x4*)(xrow + colb + bj * 128 + n * 16);
            }
#pragma unroll
            for (int m = 0; m < 4; ++m) {
                const int row = u.pm * 256 + ai * 128 + wr * 64 + m * 16 + fr;
                float ss = 0.f;
#pragma unroll
                for (int bj = 0; bj < 2; ++bj)
#pragma unroll
                    for (int n = 0; n < 2; ++n) {
                        const int col = colb + bj * 128 + n * 16;
                        const f32x4 hv = xv[m][bj][n] + acc[ai][bj][m][n];
                        *(f32x4*)(H + (size_t)row * DM + col) = hv; ss += dot4(hv, hv);
                        const f32x4 o = hv * gv[bj][n];
                        u32x2 w; w.x = cvtpk(o[0], o[1]); w.y = cvtpk(o[2], o[3]);
                        *(u32x2*)(HG + (size_t)row * DM + col) = w;
                    }
                ss += __shfl_xor(ss, 16); ss += __shfl_xor(ss, 32);
                if (fq == 0) atomicAdd(SS1 + row, ss);
            }
        }
    }
};

struct EpiGU {
    static constexpr bool PERM = true, AFTER_DRAIN = false;
    const float* SS1; bf16* ACT;
    __device__ __forceinline__ void operator()(const f32x4 (&acc)[2][2][4][2], const pg8::Unit& u, int wr, int wc, int fr, int fq) const {
#pragma unroll
        for (int ai = 0; ai < 2; ++ai)
#pragma unroll
            for (int m = 0; m < 4; ++m) {
                const int row = u.pm * 256 + ai * 128 + wr * 64 + m * 16 + fr;
                const float r = rsqrtf(SS1[row] * (1.0f / DM) + EPS);
#pragma unroll
                for (int bj = 0; bj < 2; ++bj) {
                    const int c0 = u.pn * 256 + bj * 128 + wc * 32 + 8 * fq;
                    const f32x4 gt = acc[ai][bj][m][0] * r, up = acc[ai][bj][m][1] * r;
                    f32x4 a; a.x = silu_f(gt.x) * up.x; a.y = silu_f(gt.y) * up.y; a.z = silu_f(gt.z) * up.z; a.w = silu_f(gt.w) * up.w;
                    u32x2 w; w.x = cvtpk(a[0], a[1]); w.y = cvtpk(a[2], a[3]);
                    *(u32x2*)(ACT + (size_t)row * DFF + (c0 >> 1)) = w;
                }
            }
    }
};

struct EpiDown {
    static constexpr bool PERM = false, AFTER_DRAIN = false;
    const float* H; float* Y; float* SS2;
    __device__ __forceinline__ void operator()(const f32x4 (&acc)[2][2][4][2], const pg8::Unit& u, int wr, int wc, int fr, int fq) const {
        const int colb = u.pn * 256 + wc * 32 + 4 * fq;
#pragma unroll
        for (int ai = 0; ai < 2; ++ai) {
            f32x4 hv[4][2][2];
#pragma unroll
            for (int m = 0; m < 4; ++m) {
                const int row = u.pm * 256 + ai * 128 + wr * 64 + m * 16 + fr;
#pragma unroll
                for (int bj = 0; bj < 2; ++bj)
#pragma unroll
                    for (int n = 0; n < 2; ++n) hv[m][bj][n] = *(const f32x4*)(H + (size_t)row * DM + colb + bj * 128 + n * 16);
            }
#pragma unroll
            for (int m = 0; m < 4; ++m) {
                const int row = u.pm * 256 + ai * 128 + wr * 64 + m * 16 + fr;
                float ss = 0.f;
#pragma unroll
                for (int bj = 0; bj < 2; ++bj)
#pragma unroll
                    for (int n = 0; n < 2; ++n) {
                        const f32x4 yv = hv[m][bj][n] + acc[ai][bj][m][n];
                        *(f32x4*)(Y + (size_t)row * DM + colb + bj * 128 + n * 16) = yv; ss += dot4(yv, yv);
                    }
                ss += __shfl_xor(ss, 16); ss += __shfl_xor(ss, 32);
                if (fq == 0) atomicAdd(SS2 + row, ss);
            }
        }
    }
};

__device__ __forceinline__ int gu_map(int n) { return n < DFF ? ((n >> 2) << 3) + (n & 3) : (((n - DFF) >> 2) << 3) + 4 + ((n - DFF) & 3); }

__device__ __forceinline__ void transpose_item(const float* __restrict__ W, int K, int ldn, int nblk, bf16* __restrict__ WT, int mode, LAS float* scr, int item, int lane) {
    const int kb = item / nblk, nb = item % nblk, k0 = 64 * kb, n0 = 32 * nb;
    float tv[32];
#pragma unroll
    for (int i = 0; i < 32; ++i) { const int kk = 2 * i + (lane >> 5); tv[i] = W[(size_t)(k0 + kk) * ldn + n0 + (lane & 31)]; }
#pragma unroll
    for (int i = 0; i < 32; ++i) { const int kk = 2 * i + (lane >> 5); scr[kk * 33 + (lane & 31)] = tv[i]; }
    LDS_WAIT();
    const int c = lane & 7;
#pragma unroll
    for (int j = 0; j < 4; ++j) { const int n = (lane >> 3) + 8 * j; const LAS float* s = scr + (8 * c) * 33 + n;
        u32x4 o; o.x = cvtpk(s[0 * 33], s[1 * 33]); o.y = cvtpk(s[2 * 33], s[3 * 33]); o.z = cvtpk(s[4 * 33], s[5 * 33]); o.w = cvtpk(s[6 * 33], s[7 * 33]);
        const int row = mode ? gu_map(n0 + n) : (n0 + n);
        *(u32x4*)(WT + (size_t)row * K + k0 + 8 * c) = o; }
    LDS_WAIT();
}

__device__ __forceinline__ void p0_prologue(const Params& P, LAS unsigned char* lds, int tid, int wave, int lane, int G) {
    unsigned char* ws = P.ws;
    LAS float* wdt = (LAS float*)lds;
    LAS float* scr = (LAS float*)(lds + 49152 + wave * 8704);
    const float* w_in = P.in[I_WIN];
    for (int i = tid; i < DM * 12; i += 512) { const int col = i / 12, h = i % 12; wdt[i] = w_in[(size_t)col * NINTOT + NIN + h]; }
    {
        float* ss1 = (float*)(ws + WS_SS1); float* ss2 = (float*)(ws + WS_SS2);
        for (int i = blockIdx.x * 512 + tid; i < M; i += G * 512) { ss1[i] = 0.f; ss2[i] = 0.f; }
    }
    const int gw = blockIdx.x * 8 + wave, NGW = G * 8;
    constexpr int I_IN = (DM / 64) * (NIN / 32), I_O = (DMIX / 64) * (DM / 32), I_GU = (DM / 64) * (NGU / 32), I_D = (DFF / 64) * (DM / 32);
#pragma unroll 1
    for (int it = gw; it < I_IN + I_O + I_GU + I_D; it += NGW) {
        int r = it;
        if (r < I_IN) { transpose_item(w_in, DM, NINTOT, NIN / 32, (bf16*)(ws + WS_WIN), 0, scr, r, lane); continue; } r -= I_IN;
        if (r < I_O) { transpose_item(P.in[I_WOUT], DMIX, DM, DM / 32, (bf16*)(ws + WS_WO), 0, scr, r, lane); continue; } r -= I_O;
        if (r < I_GU) { transpose_item(P.in[I_WGU], DM, NGU, NGU / 32, (bf16*)(ws + WS_WGU), 1, scr, r, lane); continue; } r -= I_GU;
        transpose_item(P.in[I_WD], DFF, DM, DM / 32, (bf16*)(ws + WS_WD), 0, scr, r, lane);
    }
    __syncthreads();
    const float* gmix = P.in[I_NMIX]; const float* dtb = P.in[I_DTB];
    bf16* XN = (bf16*)(ws + WS_XN); float* DT = (float*)(ws + WS_DT);
    f32x4 nv[4];
    if (gw < M) { const float* xr0 = gw < MP ? P.in[I_XP] + (size_t)gw * DM : P.in[I_XS] + (size_t)(gw - MP) * DM;
#pragma unroll
        for (int j = 0; j < 4; ++j) nv[j] = ((const f32x4*)xr0)[lane + 64 * j]; }
#pragma unroll 1
    for (int row = gw; row < M; row += NGW) {
        f32x4 v[4]; float ss = 0.f;
#pragma unroll
        for (int j = 0; j < 4; ++j) { v[j] = nv[j]; ss += dot4(v[j], v[j]); }
        { const int nr = row + NGW;
          if (nr < M) { const float* xr1 = nr < MP ? P.in[I_XP] + (size_t)nr * DM : P.in[I_XS] + (size_t)(nr - MP) * DM;
#pragma unroll
            for (int j = 0; j < 4; ++j) nv[j] = ((const f32x4*)xr1)[lane + 64 * j]; } }
        const float inv = rsqrtf(wave_sum(ss) * (1.0f / DM) + EPS);
        float pd[12];
#pragma unroll
        for (int h = 0; h < 12; ++h) pd[h] = 0.f;
#pragma unroll
        for (int j = 0; j < 4; ++j) {
            const f32x4 gv = ((const f32x4*)gmix)[lane + 64 * j];
            v[j] = v[j] * inv * gv;
            u32x2 w; w.x = cvtpk(v[j][0], v[j][1]); w.y = cvtpk(v[j][2], v[j][3]);
            *(u32x2*)(XN + (size_t)row * DM + 4 * (lane + 64 * j)) = w;
#pragma unroll
            for (int e = 0; e < 4; ++e) {
                const LAS f32x4* wp = (const LAS f32x4*)(wdt + (4 * (lane + 64 * j) + e) * 12);
                const f32x4 w0 = wp[0], w1 = wp[1], w2 = wp[2]; const float xv = v[j][e];
                pd[0] += xv * w0.x; pd[1] += xv * w0.y; pd[2] += xv * w0.z; pd[3] += xv * w0.w;
                pd[4] += xv * w1.x; pd[5] += xv * w1.y; pd[6] += xv * w1.z; pd[7] += xv * w1.w;
                pd[8] += xv * w2.x; pd[9] += xv * w2.y; pd[10] += xv * w2.z; pd[11] += xv * w2.w;
            }
            __builtin_amdgcn_sched_barrier(0);
        }
        float mine = 0.f;
#pragma unroll
        for (int h = 0; h < 12; ++h) { const float s = wave_sum(pd[h]); if (lane == h) mine = s; }
        if (lane < 12) DT[(size_t)row * 12 + lane] = softplus_f(mine + dtb[lane]);
    }
    __syncthreads();
}

__device__ __forceinline__ void attn_item(LAS unsigned char* lds, int item, const bf16* __restrict__ Qp, const bf16* __restrict__ Kp, const bf16* __restrict__ Vp,
                                          bf16* __restrict__ mixed, float* __restrict__ lse, int tid, int wave, int lane) {
    const int blk = item & 31, j = (item >> 5) & 3, g = (item >> 7) % 3, b = item / 384;
    const int sh = 2 * g, per_class = SEQ >> sh, nbc = per_class >> 7;
    const bool first = (blk & (nbc - 1)) == 0;
    const size_t headbase = (size_t)((b * 3 + g) * 4 + j) * SEQ * 64;
    const int fr = lane & 15, fq = lane >> 4;
    LAS unsigned char* Kl = lds;
    LAS bf16* Vt = (LAS bf16*)(lds + 36864);
    __syncthreads();
    {
        const bf16* Kb = Kp + headbase + ((size_t)blk * 128) * 64 - 128 * 64;
        const bf16* Vb = Vp + headbase + ((size_t)blk * 128) * 64 - 128 * 64;
#pragma unroll
        for (int i = 0; i < 4; ++i) {
            const int ci = tid + 512 * i, row = ci >> 3, c8 = ci & 7;
            u32x4 val = {0u, 0u, 0u, 0u};
            if (!(first && row < 128)) val = *(const u32x4*)(Kb + (size_t)row * 64 + c8 * 8);
            *(LAS u32x4*)(Kl + row * 144 + c8 * 16) = val;
        }
#pragma unroll
        for (int i = 0; i < 4; ++i) {
            const int row = lane + 64 * i, c8 = wave;
            u32x4 val = {0u, 0u, 0u, 0u};
            if (!(first && row < 128)) val = *(const u32x4*)(Vb + (size_t)row * 64 + c8 * 8);
            LAS bf16* d = Vt + (c8 * 8) * 264 + row;
            d[0 * 264] = (bf16)(val.x & 0xffff); d[1 * 264] = (bf16)(val.x >> 16);
            d[2 * 264] = (bf16)(val.y & 0xffff); d[3 * 264] = (bf16)(val.y >> 16);
            d[4 * 264] = (bf16)(val.z & 0xffff); d[5 * 264] = (bf16)(val.z >> 16);
            d[6 * 264] = (bf16)(val.w & 0xffff); d[7 * 264] = (bf16)(val.w >> 16);
        }
    }
    const bf16* Qb = Qp + headbase + (size_t)(blk * 128 + 16 * wave + fr) * 64;
    const bf16x8 qf0 = *(const bf16x8*)(Qb + fq * 8), qf1 = *(const bf16x8*)(Qb + 32 + fq * 8);
    __syncthreads();
    const int t0 = wave < 6 ? wave : 6;
    f32x4 s[10];
#pragma unroll
    for (int ti = 0; ti < 10; ++ti) {
        const int t = t0 + ti;
        const bf16x8 k0 = *(const LAS bf16x8*)(Kl + (t * 16 + fr) * 144 + fq * 16), k1 = *(const LAS bf16x8*)(Kl + (t * 16 + fr) * 144 + 64 + fq * 16);
        f32x4 a = {0.f, 0.f, 0.f, 0.f};
        a = mfma16(k0, qf0, a); a = mfma16(k1, qf1, a); s[ti] = a;
    }
    const int qi = 16 * wave + fr;
    float mx = -1e30f;
#pragma unroll
    for (int ti = 0; ti < 10; ++ti)
#pragma unroll
        for (int jj = 0; jj < 4; ++jj) {
            const int kj = (t0 + ti) * 16 + fq * 4 + jj, dist = 128 + qi - kj;
            const bool valid = dist >= 0 && dist <= 128 && (!first || kj >= 128);
            const float v = valid ? s[ti][jj] : -1e30f; s[ti][jj] = v; mx = fmaxf(mx, v);
        }
    mx = fmaxf(mx, __shfl_xor(mx, 16)); mx = fmaxf(mx, __shfl_xor(mx, 32));
    float den = 0.f;
#pragma unroll
    for (int ti = 0; ti < 10; ++ti)
#pragma unroll
        for (int jj = 0; jj < 4; ++jj) { const float p = exp2f(s[ti][jj] - mx); s[ti][jj] = p; den += p; }
    den += __shfl_xor(den, 16); den += __shfl_xor(den, 32);
    const float rden = 1.0f / den;
    f32x4 o[4];
#pragma unroll
    for (int dt = 0; dt < 4; ++dt) {
        f32x4 a = {0.f, 0.f, 0.f, 0.f};
#pragma unroll
        for (int i = 0; i < 5; ++i) {
            const LAS bf16* vr = Vt + (dt * 16 + fr) * 264 + (t0 + 2 * i) * 16 + fq * 4;
            const u32x2 lo = *(const LAS u32x2*)vr, hi = *(const LAS u32x2*)(vr + 16);
            const bf16x8 pf = mk8(cvtpk(s[2 * i][0], s[2 * i][1]), cvtpk(s[2 * i][2], s[2 * i][3]), cvtpk(s[2 * i + 1][0], s[2 * i + 1][1]), cvtpk(s[2 * i + 1][2], s[2 * i + 1][3]));
            a = mfma16(mk8(lo.x, lo.y, hi.x, hi.y), pf, a);
        }
        o[dt] = a * rden;
    }
    const int pp = blk * 128 + qi, cls = pp >> (12 - sh), ii = pp & (per_class - 1), pos = (ii << sh) + cls;
    const size_t row = (size_t)b * SEQ + pos;
#pragma unroll
    for (int dt = 0; dt < 4; ++dt) {
        u32x2 w; w.x = cvtpk(o[dt][0], o[dt][1]); w.y = cvtpk(o[dt][2], o[dt][3]);
        *(u32x2*)(mixed + row * DMIX + g * 256 + j * 64 + dt * 16 + fq * 4) = w;
    }
    if (fq == 0) lse[row * 12 + g * 4 + j] = (mx + log2f(den)) * LN2;
}

__device__ __forceinline__ void conv8(const bf16* __restrict__ xb, int t, int col, const float* __restrict__ cw, const float* __restrict__ cb, f32x4& lo, f32x4& hi) {
    f32x4 a0 = *(const f32x4*)(cb + col), a1 = *(const f32x4*)(cb + col + 4);
#pragma unroll
    for (int w = 0; w < 4; ++w) {
        const int tt = t - 3 + w;
        if (tt >= 0) {
            const u32x4 raw = *(const u32x4*)(xb + (size_t)tt * CONVD + col);
            const f32x4 w0 = *(const f32x4*)(cw + w * CONVD + col), w1 = *(const f32x4*)(cw + w * CONVD + col + 4);
            a0.x += bflo(raw.x) * w0.x; a0.y += bfhi(raw.x) * w0.y; a0.z += bflo(raw.y) * w0.z; a0.w += bfhi(raw.y) * w0.w;
            a1.x += bflo(raw.z) * w1.x; a1.y += bfhi(raw.z) * w1.y; a1.z += bflo(raw.w) * w1.z; a1.w += bfhi(raw.w) * w1.w;
        }
    }
    lo.x = silu_f(a0.x); lo.y = silu_f(a0.y); lo.z = silu_f(a0.z); lo.w = silu_f(a0.w);
    hi.x = silu_f(a1.x); hi.y = silu_f(a1.y); hi.z = silu_f(a1.z); hi.w = silu_f(a1.w);
}

__device__ __forceinline__ void scan128(float v0, float v1, int lane, float& i0, float& i1, float& total) {
    float s = v0 + v1;
#pragma unroll
    for (int o = 1; o < 64; o <<= 1) { const float t = __shfl_up(s, o); if (lane >= o) s += t; }
    i1 = s; i0 = s - v1; total = __shfl(s, 63);
}

__device__ __forceinline__ void ssd_passA_item(LAS unsigned char* lds, int item, const Params& P, int tid, int wave, int lane) {
    const int g = item & 3, c = (item >> 2) & 31, b = item >> 7;
    unsigned char* ws = P.ws;
    const bf16* xb = (const bf16*)(ws + WS_XBC) + (size_t)b * SEQ * CONVD;
    bf16* xcb = (bf16*)(ws + WS_XC) + (size_t)b * SEQ * CONVD;
    const float* DT = (const float*)(ws + WS_DT);
    float* SLOC = (float*)(ws + WS_SLOC); float* CD = (float*)(ws + WS_CD);
    const float* cw = P.in[I_CW]; const float* cb = P.in[I_CB];
    LAS float* tabw = (LAS float*)lds;
    LAS bf16* xT = (LAS bf16*)(lds + 2048);
    LAS bf16* BT = (LAS bf16*)(lds + 2048 + 52224);
    const int fr = lane & 15, fq = lane >> 4;
    const int oct = tid % 56, seg = tid / 56, l0 = seg * 16;
    const int col = oct < 24 ? g * 192 + oct * 8 : (oct < 40 ? DINNER + g * 128 + (oct - 24) * 8 : DINNER + 512 + g * 128 + (oct - 40) * 8);
    const int t0 = c * 128 + l0;
    __syncthreads();
    if (wave < 3) {
        const int h = g * 3 + wave; const float a = -__expf(P.in[I_ALOG][h]);
        const size_t r0 = (size_t)b * SEQ + c * 128 + 2 * lane;
        const float d0 = DT[r0 * 12 + h], d1 = DT[(r0 + 1) * 12 + h];
        float i0, i1, tot; scan128(d0 * a, d1 * a, lane, i0, i1, tot);
        tabw[wave * 128 + 2 * lane] = __expf(tot - i0) * d0; tabw[wave * 128 + 2 * lane + 1] = __expf(tot - i1) * d1;
        if (lane == 0) CD[(b * NCH + c) * NH + h] = __expf(tot);
    }
    __syncthreads();
    if (tid < 448) {
        f32x4 wv[4][2], bias[2];
#pragma unroll
        for (int w = 0; w < 4; ++w) { wv[w][0] = *(const f32x4*)(cw + w * CONVD + col); wv[w][1] = *(const f32x4*)(cw + w * CONVD + col + 4); }
        bias[0] = *(const f32x4*)(cb + col); bias[1] = *(const f32x4*)(cb + col + 4);
        const int hh = oct >> 3;
        LAS bf16* dT = oct < 24 ? xT + (hh * 64 + (oct & 7) * 8) * 136 + l0 : BT + ((oct - 24) * 8) * 136 + l0;
#pragma unroll 1
        for (int half = 0; half < 4; ++half) {
            const int th = t0 + 4 * half;
            u32x4 raw[7];
#pragma unroll
            for (int r = 0; r < 7; ++r) { const int tt = th - 3 + r; raw[r] = (u32x4){0u, 0u, 0u, 0u}; if (tt >= 0) raw[r] = *(const u32x4*)(xb + (size_t)tt * CONVD + col); }
#pragma unroll
            for (int lp = 0; lp < 2; ++lp) {
                f32x4 o[2][2];
#pragma unroll
                for (int q = 0; q < 2; ++q) {
                    f32x4 a0 = bias[0], a1 = bias[1];
#pragma unroll
                    for (int w = 0; w < 4; ++w) {
                        const u32x4 r = raw[2 * lp + q + w];
                        a0.x += bflo(r.x) * wv[w][0].x; a0.y += bfhi(r.x) * wv[w][0].y; a0.z += bflo(r.y) * wv[w][0].z; a0.w += bfhi(r.y) * wv[w][0].w;
                        a1.x += bflo(r.z) * wv[w][1].x; a1.y += bfhi(r.z) * wv[w][1].y; a1.z += bflo(r.w) * wv[w][1].z; a1.w += bfhi(r.w) * wv[w][1].w;
                    }
                    o[q][0] = (f32x4){silu_f(a0.x), silu_f(a0.y), silu_f(a0.z), silu_f(a0.w)};
                    o[q][1] = (f32x4){silu_f(a1.x), silu_f(a1.y), silu_f(a1.z), silu_f(a1.w)};
                    u32x4 w4; w4.x = cvtpk(o[q][0].x, o[q][0].y); w4.y = cvtpk(o[q][0].z, o[q][0].w); w4.z = cvtpk(o[q][1].x, o[q][1].y); w4.w = cvtpk(o[q][1].z, o[q][1].w);
                    *(u32x4*)(xcb + (size_t)(th + 2 * lp + q) * CONVD + col) = w4;
                }
                if (oct < 40) {
                    const int lo2 = 4 * half + 2 * lp;
                    float s0 = 1.f, s1 = 1.f;
                    if (oct < 24) { s0 = tabw[hh * 128 + l0 + lo2]; s1 = tabw[hh * 128 + l0 + lo2 + 1]; }
                    LAS unsigned* d = (LAS unsigned*)(dT + lo2);
                    d[0 * 68] = cvtpk(o[0][0].x * s0, o[1][0].x * s1); d[1 * 68] = cvtpk(o[0][0].y * s0, o[1][0].y * s1);
                    d[2 * 68] = cvtpk(o[0][0].z * s0, o[1][0].z * s1); d[3 * 68] = cvtpk(o[0][0].w * s0, o[1][0].w * s1);
                    d[4 * 68] = cvtpk(o[0][1].x * s0, o[1][1].x * s1); d[5 * 68] = cvtpk(o[0][1].y * s0, o[1][1].y * s1);
                    d[6 * 68] = cvtpk(o[0][1].z * s0, o[1][1].z * s1); d[7 * 68] = cvtpk(o[0][1].w * s0, o[1][1].w * s1);
                }
            }
        }
    }
    __syncthreads();
    bf16x8 bfr[4];
#pragma unroll
    for (int ks = 0; ks < 4; ++ks) bfr[ks] = *(const LAS bf16x8*)(BT + (wave * 16 + fr) * 136 + ks * 32 + fq * 8);
#pragma unroll
    for (int hh = 0; hh < 3; ++hh)
#pragma unroll
        for (int pt = 0; pt < 4; ++pt) {
            f32x4 acc = {0.f, 0.f, 0.f, 0.f};
#pragma unroll
            for (int ks = 0; ks < 4; ++ks) acc = mfma16(*(const LAS bf16x8*)(xT + (hh * 64 + pt * 16 + fr) * 136 + ks * 32 + fq * 8), bfr[ks], acc);
            float* dst = SLOC + ((((size_t)(b * NCH + c) * NH + g * 3 + hh) * 64 + pt * 16 + fq * 4) * 128) + wave * 16 + fr;
#pragma unroll
            for (int jj = 0; jj < 4; ++jj) dst[jj * 128] = acc[jj];
        }
}

__device__ __forceinline__ void ssd_sample_item(LAS unsigned char* lds, int b, const Params& P, int tid, int wave, int lane) {
    unsigned char* ws = P.ws;
    const bf16* XBC = (const bf16*)(ws + WS_XBC); const bf16* Z = (const bf16*)(ws + WS_Z); const float* DT = (const float*)(ws + WS_DT);
    bf16* mixed = (bf16*)(ws + WS_MIX);
    const float* cw = P.in[I_CW]; const float* cb = P.in[I_CB]; const float* sconv = P.in[I_SCONV]; const float* sssm = P.in[I_SSSM];
    float* out_ssm = P.out + O_SSSM;
    LAS float* xc = (LAS float*)lds;
    LAS float* dts = (LAS float*)(lds + 28672);
    LAS float* yg = (LAS float*)(lds + 28928);
    __syncthreads();
    if (tid < CONVD / 8) {
        const int col = tid * 8;
        f32x4 xin[7][2];
#pragma unroll
        for (int r = 0; r < 3; ++r) { const float* sp = sconv + ((size_t)b * 3 + r) * CONVD + col; xin[r][0] = *(const f32x4*)sp; xin[r][1] = *(const f32x4*)(sp + 4); }
#pragma unroll
        for (int r = 0; r < 4; ++r) { const u32x4 v = *(const u32x4*)(XBC + ((size_t)MP + b * 4 + r) * CONVD + col);
            xin[3 + r][0] = (f32x4){bflo(v.x), bfhi(v.x), bflo(v.y), bfhi(v.y)}; xin[3 + r][1] = (f32x4){bflo(v.z), bfhi(v.z), bflo(v.w), bfhi(v.w)}; }
        f32x4 wv[4][2];
#pragma unroll
        for (int w = 0; w < 4; ++w) { wv[w][0] = *(const f32x4*)(cw + w * CONVD + col); wv[w][1] = *(const f32x4*)(cw + w * CONVD + col + 4); }
        const f32x4 b0 = *(const f32x4*)(cb + col), b1 = *(const f32x4*)(cb + col + 4);
#pragma unroll
        for (int s = 0; s < 4; ++s) {
            f32x4 a0 = b0, a1 = b1;
#pragma unroll
            for (int w = 0; w < 4; ++w) { a0 += xin[s + w][0] * wv[w][0]; a1 += xin[s + w][1] * wv[w][1]; }
            *(LAS f32x4*)(xc + s * CONVD + col) = (f32x4){silu_f(a0.x), silu_f(a0.y), silu_f(a0.z), silu_f(a0.w)};
            *(LAS f32x4*)(xc + s * CONVD + col + 4) = (f32x4){silu_f(a1.x), silu_f(a1.y), silu_f(a1.z), silu_f(a1.w)};
        }
    }
    if (tid < 48) dts[tid] = DT[((size_t)MP + b * 4 + tid / 12) * 12 + tid % 12];
    LAS float* zs = (LAS float*)(lds + 41216);
    for (int i = tid; i < 4 * DINNER / 2; i += 512) { const unsigned zz = *(const unsigned*)(Z + ((size_t)MP + b * 4) * DINNER + 2 * i); zs[2 * i] = bflo(zz); zs[2 * i + 1] = bfhi(zz); }
    __syncthreads();
    const int p = tid >> 3, nq = tid & 7, n0 = nq * 16;
    f32x4 nx[4], nx2[4];
    const size_t so0 = ((size_t)(b * NH) * 64 + p) * 128 + n0;
#pragma unroll
    for (int i = 0; i < 4; ++i) { nx[i] = __builtin_nontemporal_load((const f32x4*)(sssm + so0 + 4 * i)); nx2[i] = __builtin_nontemporal_load((const f32x4*)(sssm + so0 + 64 * 128 + 4 * i)); }
#pragma unroll 1
    for (int h = 0; h < NH; ++h) {
        const int g = h / 3;
        const size_t so = so0 + (size_t)h * 64 * 128;
        f32x4 st[4];
#pragma unroll
        for (int i = 0; i < 4; ++i) { st[i] = nx[i]; nx[i] = nx2[i]; }
        if (h + 2 < NH) {
#pragma unroll
            for (int i = 0; i < 4; ++i) nx2[i] = __builtin_nontemporal_load((const f32x4*)(sssm + so + 2 * 64 * 128 + 4 * i));
        }
        const float a = -__expf(P.in[I_ALOG][h]), Dh = P.in[I_DSKIP][h];
#pragma unroll
        for (int s = 0; s < 4; ++s) {
            const float dt = dts[s * 12 + h], dA = __expf(dt * a), xv = xc[s * CONVD + h * 64 + p], xdt = xv * dt;
            const LAS f32x4* Bv = (const LAS f32x4*)(xc + s * CONVD + DINNER + g * 128 + n0);
            const LAS f32x4* Cv = (const LAS f32x4*)(xc + s * CONVD + DINNER + 512 + g * 128 + n0);
            float y = 0.f;
#pragma unroll
            for (int i = 0; i < 4; ++i) { st[i] = st[i] * dA + Bv[i] * xdt; y += dot4(Cv[i], st[i]); }
            y += __shfl_xor(y, 1); y += __shfl_xor(y, 2); y += __shfl_xor(y, 4);
            if (nq == 0) { const float z = zs[s * DINNER + h * 64 + p]; yg[s * DINNER + h * 64 + p] = (y + Dh * xv) * silu_f(z); }
        }
#pragma unroll
        for (int i = 0; i < 4; ++i) __builtin_nontemporal_store(st[i], (f32x4*)(out_ssm + so + 4 * i));
    }
    __syncthreads();
    if (wave < 4) {
        const int s = wave; float ss = 0.f;
#pragma unroll
        for (int k = 0; k < 12; ++k) { const float v = yg[s * DINNER + lane + 64 * k]; ss += v * v; }
        const float inv = rsqrtf(wave_sum(ss) * (1.0f / DINNER) + EPS);
        const float* gs = P.in[I_NSSD];
#pragma unroll
        for (int k = 0; k < 12; ++k) { const int cc = lane + 64 * k; const float v = yg[s * DINNER + cc] * inv * gs[cc];
            mixed[((size_t)MP + b * 4 + s) * DMIX + DATT + cc] = (bf16)(cvtpk(v, 0.f) & 0xffff); }
    }
}

__device__ __forceinline__ const float* kv_row(const float* cache, const float* skv, int b, int lb, int idx) {
    return idx < lb ? cache + ((size_t)b * lb + idx) * 512 : skv + ((size_t)b * lb + (idx - 4)) * 512;
}
__device__ __forceinline__ void attn_sample_item(LAS unsigned char* lds, int item, const Params& P, int tid, int wave, int lane) {
    const int g = item % 3, b = item / 3;
    unsigned char* ws = P.ws;
    const float* QS = (const float*)(ws + WS_QS); bf16* mixed = (bf16*)(ws + WS_MIX); float* LSE = (float*)(ws + WS_LSE);
    LAS float* pl = (LAS float*)lds;
    const int sh = 2 * g, lb = 128 << sh;
    const float* cache = g == 0 ? P.in[I_C1] : (g == 1 ? P.in[I_C4] : P.in[I_C16]);
    const float* skv = P.out + (g == 0 ? O_SKV1 : (g == 1 ? O_SKV4 : O_SKV16));
    const int q4 = lane >> 4, l16 = lane & 15;
    __syncthreads();
#pragma unroll 1
    for (int k = 0; k < 2; ++k) {
        const int pi = wave * 2 + k, j = pi >> 2, s = pi & 3;
        const size_t row = (size_t)MP + b * 4 + s;
        {
            const f32x4 qv = *(const f32x4*)(QS + ((size_t)b * 4 + s) * DATT + g * 256 + j * 64 + l16 * 4) * ATT_SCALE;
#pragma unroll 1
            for (int bt = 0; bt < 3; ++bt) {
                f32x4 kv[11];
#pragma unroll
                for (int i = 0; i < 11; ++i) {
                    const int jj = (bt * 11 + i) * 4 + q4; int idx = lb + s - (jj << sh);
                    if (jj > 128 || idx < 0) idx = 0;
                    kv[i] = *(const f32x4*)(kv_row(cache, skv, b, lb, idx) + j * 64 + l16 * 4);
                }
#pragma unroll
                for (int i = 0; i < 11; ++i) {
                    const int jj = (bt * 11 + i) * 4 + q4; const int idx = lb + s - (jj << sh);
                    const bool valid = jj <= 128 && idx >= 0;
                    float d = dot4(kv[i], qv);
                    d += __shfl_xor(d, 1); d += __shfl_xor(d, 2); d += __shfl_xor(d, 4); d += __shfl_xor(d, 8);
                    pl[l16 == 0 ? wave * 132 + jj : 1056 + lane] = valid ? d : -1e30f;
                }
            }
        }
        LDS_WAIT();
        float sc[3];
#pragma unroll
        for (int u = 0; u < 3; ++u) { const int jj = lane + 64 * u; sc[u] = jj < 132 ? pl[wave * 132 + jj] : -1e30f; }
        const float mx = wave_max(fmaxf(fmaxf(sc[0], sc[1]), sc[2]));
        float den = 0.f;
#pragma unroll
        for (int u = 0; u < 3; ++u) { const int jj = lane + 64 * u; const float p = sc[u] > -1e29f ? __expf(sc[u] - mx) : 0.f; den += p; if (jj < 132) pl[wave * 132 + jj] = p; }
        den = wave_sum(den);
        LDS_WAIT();
        f32x4 o = {0.f, 0.f, 0.f, 0.f};
        {
#pragma unroll 1
            for (int bt = 0; bt < 3; ++bt) {
                f32x4 vv[11];
#pragma unroll
                for (int i = 0; i < 11; ++i) {
                    const int jj = (bt * 11 + i) * 4 + q4; int idx = lb + s - (jj << sh); if (jj > 128 || idx < 0) idx = 0;
                    vv[i] = *(const f32x4*)(kv_row(cache, skv, b, lb, idx) + 256 + j * 64 + l16 * 4);
                }
#pragma unroll
                for (int i = 0; i < 11; ++i) o += vv[i] * pl[wave * 132 + (bt * 11 + i) * 4 + q4];
            }
        }
#pragma unroll
        for (int e = 0; e < 4; ++e) { o[e] += __shfl_xor(o[e], 16); o[e] += __shfl_xor(o[e], 32); }
        o = o * (1.0f / den);
        if (q4 == 0) { u32x2 w; w.x = cvtpk(o[0], o[1]); w.y = cvtpk(o[2], o[3]); *(u32x2*)(mixed + row * DMIX + g * 256 + j * 64 + l16 * 4) = w; }
        if (lane == 0) LSE[row * 12 + g * 4 + j] = mx + __logf(den);
        LDS_WAIT();
    }
}

constexpr int NCOPY = DB * (2 + 8 + 32);
struct CopyDesc { const f32x4* src; f32x4* dst; int n4; };
__device__ __forceinline__ CopyDesc copy_desc(int ci, const Params& P) {
    int g, b, ch;
    if (ci < DB * 2) { g = 0; b = ci >> 1; ch = ci & 1; }
    else if (ci < DB * 10) { ci -= DB * 2; g = 1; b = ci >> 3; ch = ci & 7; }
    else { ci -= DB * 10; g = 2; b = ci >> 5; ch = ci & 31; }
    const int lb = 128 << (2 * g), row0 = ch * 64;
    int nrows = lb - 4 - row0; if (nrows > 64) nrows = 64;
    CopyDesc d;
    d.src = (const f32x4*)((g == 0 ? P.in[I_C1] : (g == 1 ? P.in[I_C4] : P.in[I_C16])) + ((size_t)b * lb + 4 + row0) * 512);
    d.dst = (f32x4*)(P.out + (g == 0 ? O_SKV1 : (g == 1 ? O_SKV4 : O_SKV16)) + ((size_t)b * lb + row0) * 512);
    d.n4 = nrows * 128;
    return d;
}

__device__ __forceinline__ void p2b_scan(const Params& P, int tid, int G) {
    unsigned char* ws = P.ws;
    const float* __restrict__ SLOC = (const float*)(ws + WS_SLOC); const float* __restrict__ CD = (const float*)(ws + WS_CD); bf16* __restrict__ HP = (bf16*)(ws + WS_HPREV);
    float* __restrict__ pssm = P.out + O_PSSM;
    constexpr int NV = NB * NH * 64 * 32;
    for (int v = blockIdx.x * 512 + tid; v < NV; v += G * 512) {
        const int n4 = v & 31, p = (v >> 5) & 63, bh = v >> 11, b = bh / NH, h = bh % NH;
        f32x4 run = {0.f, 0.f, 0.f, 0.f};
#pragma unroll 8
        for (int c = 0; c < NCH; ++c) {
            const size_t off = (((size_t)(b * NCH + c) * NH + h) * 64 + p) * 128 + n4 * 4;
            const f32x4 sv = __builtin_nontemporal_load((const f32x4*)(SLOC + off)); const float cd = CD[(b * NCH + c) * NH + h];
            u32x2 w; w.x = cvtpk(run.x, run.y); w.y = cvtpk(run.z, run.w);
            *(u32x2*)(HP + off) = w;
            run = run * cd + sv;
        }
        *(f32x4*)(pssm + ((size_t)(b * NH + h) * 64 + p) * 128 + n4 * 4) = run;
    }
}

__device__ __forceinline__ void alpha_rows(bf16* __restrict__ mixed, const float* __restrict__ LSE, size_t r0, int tid) {
    u32x4 v[12]; float al[12];
#pragma unroll
    for (int i = 0; i < 12; ++i) {
        const int wi = tid + 512 * i, rr = wi / 96, oc = wi % 96, c0 = oc * 8, g = c0 >> 8, j = (c0 >> 6) & 3;
        const float* lp = LSE + (r0 + rr) * 12 + j;
        const float l0 = lp[0], l1 = lp[4], l2 = lp[8];
        v[i] = *(const u32x4*)(mixed + (r0 + rr) * DMIX + c0);
        const float mx = fmaxf(l0, fmaxf(l1, l2)), e0 = __expf(l0 - mx), e1 = __expf(l1 - mx), e2 = __expf(l2 - mx);
        al[i] = (g == 0 ? e0 : (g == 1 ? e1 : e2)) / (e0 + e1 + e2);
    }
#pragma unroll
    for (int i = 0; i < 12; ++i) {
        const int wi = tid + 512 * i, rr = wi / 96, oc = wi % 96, c0 = oc * 8; const float a = al[i];
        u32x4 w; w.x = cvtpk(bflo(v[i].x) * a, bfhi(v[i].x) * a); w.y = cvtpk(bflo(v[i].y) * a, bfhi(v[i].y) * a); w.z = cvtpk(bflo(v[i].z) * a, bfhi(v[i].z) * a); w.w = cvtpk(bflo(v[i].w) * a, bfhi(v[i].w) * a);
        *(u32x4*)(mixed + (r0 + rr) * DMIX + c0) = w;
    }
}

__device__ __forceinline__ void p2c_item(LAS unsigned char* lds, int item, const Params& P, int tid, int wave, int lane, bool do_alpha = true) {
    const int hf = item & 1, c = (item >> 1) & 31, b = item >> 6;
    unsigned char* ws = P.ws;
    const bf16* xcb = (const bf16*)(ws + WS_XC) + (size_t)b * SEQ * CONVD;
    const float* DT = (const float*)(ws + WS_DT); const bf16* HP = (const bf16*)(ws + WS_HPREV); const bf16* Z = (const bf16*)(ws + WS_Z);
    bf16* mixed = (bf16*)(ws + WS_MIX); const float* LSE = (const float*)(ws + WS_LSE);
    LAS bf16* Bn = (LAS bf16*)lds;
    LAS bf16* Cn = (LAS bf16*)(lds + 34816);
    LAS bf16* xT = (LAS bf16*)(lds + 52224);
    LAS float* tdt = (LAS float*)(lds + 104448);
    LAS float* tac = (LAS float*)(lds + 105984);
    LAS float* ssl = (LAS float*)(lds + 107520);
    const int fr = lane & 15, fq = lane >> 4, rt = wave & 3, ph = wave >> 2;
    const int smax = 64 * (hf + 1), lg = 64 * hf + 16 * rt + fr;
    const size_t row = (size_t)b * SEQ + c * 128 + lg;
    const int npairs = ((hf * 4 + rt) >> 1) + 1;
    float ssq = 0.f;
    for (int g = 0; g < 4; ++g) {
        __syncthreads();
        if (wave < 3) {
            const int h = g * 3 + wave; const float a = -__expf(P.in[I_ALOG][h]);
            const size_t r0 = (size_t)b * SEQ + c * 128 + 2 * lane;
            const float d0 = DT[r0 * 12 + h], d1 = DT[(r0 + 1) * 12 + h];
            float i0, i1, tot; scan128(d0 * a, d1 * a, lane, i0, i1, tot);
            tdt[wave * 128 + 2 * lane] = d0; tdt[wave * 128 + 2 * lane + 1] = d1;
            tac[wave * 128 + 2 * lane] = i0; tac[wave * 128 + 2 * lane + 1] = i1;
        }
        if (tid >= 192) {
            u32x4 sv[10];
#pragma unroll
            for (int i = 0; i < 10; ++i) {
                const int wi = tid - 192 + 320 * i; sv[i] = (u32x4){0u, 0u, 0u, 0u};
                if (wi < smax * 16) { const int oct = wi & 15, s = wi >> 4; sv[i] = *(const u32x4*)(xcb + (size_t)(c * 128 + s) * CONVD + DINNER + g * 128 + oct * 8); }
                else if (wi < smax * 16 + 1024) { const int w2 = wi - smax * 16, oct = w2 & 15, l = w2 >> 4; sv[i] = *(const u32x4*)(xcb + (size_t)(c * 128 + 64 * hf + l) * CONVD + DINNER + 512 + g * 128 + oct * 8); }
            }
#pragma unroll
            for (int i = 0; i < 10; ++i) {
                const int wi = tid - 192 + 320 * i;
                if (wi < smax * 16) { const int oct = wi & 15, s = wi >> 4; *(LAS u32x4*)(Bn + s * 136 + oct * 8) = sv[i]; }
                else if (wi < smax * 16 + 1024) { const int w2 = wi - smax * 16, oct = w2 & 15, l = w2 >> 4; *(LAS u32x4*)(Cn + l * 136 + oct * 8) = sv[i]; }
            }
        } else if (tid < 24 * (smax >> 4)) {
            const int oct = tid % 24, seg = tid / 24, s0 = seg * 16, hh = oct >> 3;
            u32x4 r[16];
#pragma unroll
            for (int i = 0; i < 16; ++i) r[i] = *(const u32x4*)(xcb + (size_t)(c * 128 + s0 + i) * CONVD + g * 192 + oct * 8);
            LAS unsigned* d = (LAS unsigned*)(xT + (hh * 64 + (oct & 7) * 8) * 136 + s0);
#pragma unroll
            for (int i = 0; i < 8; ++i) {
                const u32x4 a0 = r[2 * i], a1 = r[2 * i + 1];
                d[0 * 68 + i] = (a0.x & 0xffffu) | (a1.x << 16); d[1 * 68 + i] = (a0.x >> 16) | (a1.x & 0xffff0000u);
                d[2 * 68 + i] = (a0.y & 0xffffu) | (a1.y << 16); d[3 * 68 + i] = (a0.y >> 16) | (a1.y & 0xffff0000u);
                d[4 * 68 + i] = (a0.z & 0xffffu) | (a1.z << 16); d[5 * 68 + i] = (a0.z >> 16) | (a1.z & 0xffff0000u);
                d[6 * 68 + i] = (a0.w & 0xffffu) | (a1.w << 16); d[7 * 68 + i] = (a0.w >> 16) | (a1.w & 0xffff0000u);
            }
        }
        __syncthreads();
        bf16x8 cfr[4];
#pragma unroll
        for (int ks = 0; ks < 4; ++ks) cfr[ks] = *(const LAS bf16x8*)(Cn + (16 * rt + fr) * 136 + ks * 32 + fq * 8);
        f32x4 accY[3][2];
#pragma unroll
        for (int h = 0; h < 3; ++h) { accY[h][0] = (f32x4){0.f, 0.f, 0.f, 0.f}; accY[h][1] = (f32x4){0.f, 0.f, 0.f, 0.f}; }
        float acl[3];
#pragma unroll
        for (int h = 0; h < 3; ++h) acl[h] = tac[h * 128 + lg];
        const bf16* hpb = HP + ((((size_t)(b * NCH + c) * NH + g * 3) * 64 + 2 * ph * 16 + fr) * 128) + fq * 8;
        bf16x8 hpc[2][4];
#pragma unroll
        for (int pti = 0; pti < 2; ++pti)
#pragma unroll
            for (int ks = 0; ks < 4; ++ks) hpc[pti][ks] = *(const bf16x8*)(hpb + pti * 16 * 128 + ks * 32);
        for (int sp = 0; sp < npairs; ++sp) {
            f32x4 cbv[2];
#pragma unroll
            for (int u = 0; u < 2; ++u) {
                f32x4 a = {0.f, 0.f, 0.f, 0.f};
#pragma unroll
                for (int ks = 0; ks < 4; ++ks) a = mfma16(*(const LAS bf16x8*)(Bn + ((2 * sp + u) * 16 + fr) * 136 + ks * 32 + fq * 8), cfr[ks], a);
                cbv[u] = a;
            }
#pragma unroll
            for (int h = 0; h < 3; ++h) {
                float mv[8];
#pragma unroll
                for (int u = 0; u < 2; ++u) {
                    const int s0 = (2 * sp + u) * 16 + fq * 4;
                    const f32x4 as = *(const LAS f32x4*)(tac + h * 128 + s0), ds = *(const LAS f32x4*)(tdt + h * 128 + s0);
#pragma unroll
                    for (int jj = 0; jj < 4; ++jj) {
                        const float e = fminf(acl[h] - as[jj], 0.f);
                        mv[u * 4 + jj] = (s0 + jj <= lg) ? cbv[u][jj] * __expf(e) * ds[jj] : 0.f;
                    }
                }
                const bf16x8 pf = mk8(cvtpk(mv[0], mv[1]), cvtpk(mv[2], mv[3]), cvtpk(mv[4], mv[5]), cvtpk(mv[6], mv[7]));
#pragma unroll
                for (int pti = 0; pti < 2; ++pti) {
                    const LAS bf16* xr = xT + (h * 64 + (2 * ph + pti) * 16 + fr) * 136 + (2 * sp) * 16 + fq * 4;
                    const u32x2 lo = *(const LAS u32x2*)xr, hi = *(const LAS u32x2*)(xr + 16);
                    accY[h][pti] = mfma16(mk8(lo.x, lo.y, hi.x, hi.y), pf, accY[h][pti]);
                }
            }
        }
#pragma unroll
        for (int h = 0; h < 3; ++h) {
            const int hd = g * 3 + h; const float Dh = P.in[I_DSKIP][hd], eal = __expf(acl[h]);
            bf16x8 hpn[2][4];
            if (h < 2) {
#pragma unroll
                for (int pti = 0; pti < 2; ++pti)
#pragma unroll
                    for (int ks = 0; ks < 4; ++ks) hpn[pti][ks] = *(const bf16x8*)(hpb + (size_t)(h + 1) * 64 * 128 + pti * 16 * 128 + ks * 32);
            }
#pragma unroll
            for (int pti = 0; pti < 2; ++pti) {
                const int pt = 2 * ph + pti;
                f32x4 a = {0.f, 0.f, 0.f, 0.f};
#pragma unroll
                for (int ks = 0; ks < 4; ++ks) a = mfma16(hpc[pti][ks], cfr[ks], a);
                const f32x4 y = accY[h][pti] + a * eal;
                const int pc = hd * 64 + pt * 16 + fq * 4;
                const u32x2 zr = *(const u32x2*)(Z + row * DINNER + pc);
                const float z0 = bflo(zr.x), z1 = bfhi(zr.x), z2 = bflo(zr.y), z3 = bfhi(zr.y);
                const LAS bf16* xc = xT + (h * 64 + pt * 16 + fq * 4) * 136 + lg;
                const float y0 = (y[0] + Dh * bf2f(xc[0])) * silu_f(z0), y1 = (y[1] + Dh * bf2f(xc[136])) * silu_f(z1);
                const float y2 = (y[2] + Dh * bf2f(xc[2 * 136])) * silu_f(z2), y3 = (y[3] + Dh * bf2f(xc[3 * 136])) * silu_f(z3);
                ssq += (y0 * y0 + y1 * y1) + (y2 * y2 + y3 * y3);
                u32x2 w; w.x = cvtpk(y0, y1); w.y = cvtpk(y2, y3);
                *(u32x2*)(mixed + row * DMIX + DATT + pc) = w;
            }
            if (h < 2) {
#pragma unroll
                for (int pti = 0; pti < 2; ++pti)
#pragma unroll
                    for (int ks = 0; ks < 4; ++ks) hpc[pti][ks] = hpn[pti][ks];
            }
        }
    }
    ssq += __shfl_xor(ssq, 16); ssq += __shfl_xor(ssq, 32);
    if (fq == 0) ssl[ph * 64 + 16 * rt + fr] = ssq;
    __syncthreads();
    {
        const float tot = ssl[16 * rt + fr] + ssl[64 + 16 * rt + fr];
        const float inv = rsqrtf(tot * (1.0f / DINNER) + EPS);
        const float* __restrict__ gs = P.in[I_NSSD];
#pragma unroll
        for (int hh = 0; hh < 2; ++hh) {
            u32x2 rv[6][2]; f32x4 gv[6][2];
#pragma unroll
            for (int k = 0; k < 6; ++k)
#pragma unroll
                for (int pti = 0; pti < 2; ++pti) {
                    const int pc = (hh * 6 + k) * 64 + (2 * ph + pti) * 16 + fq * 4;
                    rv[k][pti] = *(const u32x2*)(mixed + row * DMIX + DATT + pc); gv[k][pti] = *(const f32x4*)(gs + pc);
                }
#pragma unroll
            for (int k = 0; k < 6; ++k)
#pragma unroll
                for (int pti = 0; pti < 2; ++pti) {
                    const int pc = (hh * 6 + k) * 64 + (2 * ph + pti) * 16 + fq * 4;
                    const u32x2 v = rv[k][pti]; const f32x4 g4 = gv[k][pti];
                    u32x2 w; w.x = cvtpk(bflo(v.x) * inv * g4.x, bfhi(v.x) * inv * g4.y); w.y = cvtpk(bflo(v.y) * inv * g4.z, bfhi(v.y) * inv * g4.w);
                    *(u32x2*)(mixed + row * DMIX + DATT + pc) = w;
                }
        }
    }
    if (do_alpha) alpha_rows(mixed, LSE, (size_t)b * SEQ + c * 128 + 64 * hf, tid);
}

__device__ __forceinline__ void p6_final(const Params& P, int wave, int lane, int G) {
    const float* SS2 = (const float*)(P.ws + WS_SS2); const float* gf = P.in[I_NFIN];
    const int gw = blockIdx.x * 8 + wave, NGW = G * 8;
    f32x4 gv[4];
#pragma unroll
    for (int j = 0; j < 4; ++j) gv[j] = ((const f32x4*)gf)[lane + 64 * j];
    f32x4 nv[4]; float ns = 0.f;
    if (gw < M) { ns = SS2[gw];
#pragma unroll
        for (int j = 0; j < 4; ++j) nv[j] = __builtin_nontemporal_load((const f32x4*)(P.out + (size_t)gw * DM) + lane + 64 * j); }
#pragma unroll 1
    for (int row = gw; row < M; row += NGW) {
        f32x4 v[4]; const float s2 = ns;
#pragma unroll
        for (int j = 0; j < 4; ++j) v[j] = nv[j];
        const int nr = row + NGW;
        if (nr < M) { ns = SS2[nr];
#pragma unroll
            for (int j = 0; j < 4; ++j) nv[j] = __builtin_nontemporal_load((const f32x4*)(P.out + (size_t)nr * DM) + lane + 64 * j); }
        const float inv = rsqrtf(s2 * (1.0f / DM) + EPS);
        f32x4* yr = (f32x4*)(P.out + (size_t)row * DM);
#pragma unroll
        for (int j = 0; j < 4; ++j) __builtin_nontemporal_store(v[j] * inv * gv[j], yr + lane + 64 * j);
    }
}

#define XB_TMO      128
#define XB_XCNT(j)  (256  + 64 * (j))
#define XB_XSUB(j)  (1280 + 64 * (j))
#define XB_XGEN(j)  (2304 + 64 * (j))
#define XB_TOP      3328
#define XB_TOPGEN   3392
#define XCD_BAR_WORDS 3456
#define XB_SPIN_CAP (1u << 18)

__device__ __forceinline__ unsigned xb_ld(unsigned* p)              { return __hip_atomic_load(p, __ATOMIC_RELAXED, __HIP_MEMORY_SCOPE_AGENT); }
__device__ __forceinline__ unsigned xb_add(unsigned* p, unsigned v) { return __hip_atomic_fetch_add(p, v, __ATOMIC_RELAXED, __HIP_MEMORY_SCOPE_AGENT); }
__device__ __forceinline__ unsigned xb_xcc_id() { return (unsigned)__builtin_amdgcn_s_getreg((3 << 11) | 20) & 0xFu; }
#define XB_SPIN(cond, bar) do { unsigned _sp = 0; while (cond) { __builtin_amdgcn_s_sleep(1); \
    if ((++_sp & 255u) == 0u) { if (xb_ld(&(bar)[XB_TMO])) break; if (_sp > XB_SPIN_CAP) { atomicAdd(&(bar)[XB_TMO], 1u); break; } } } } while (0)

struct XcdBarrier {
    unsigned* bar; unsigned x;
    volatile LAS unsigned* st;
};

__device__ __forceinline__ XcdBarrier xcd_barrier_post(unsigned* bar, volatile LAS unsigned* st) {
    XcdBarrier b; b.bar = bar; b.x = xb_xcc_id(); b.st = st;
    if (threadIdx.x == 0) (void)xb_add(&bar[XB_XCNT(b.x)], 1u);
    return b;
}
__device__ __forceinline__ void xcd_barrier_complete(unsigned* bar, unsigned x, unsigned& nloc, unsigned& nx) {
    const unsigned G = gridDim.x * gridDim.y * gridDim.z;
    unsigned sum, cnt, mine, sp = 0u;
    for (;;) {
        sum = 0u; cnt = 0u; mine = 0u;
#pragma unroll
        for (unsigned j = 0; j < 16; ++j) { const unsigned c = xb_ld(&bar[XB_XCNT(j)]); sum += c; cnt += (c > 0u) ? 1u : 0u; mine = (j == x) ? c : mine; }
        if (sum == G) break;
        __builtin_amdgcn_s_sleep(1);
        if ((++sp & 255u) == 0u) { if (xb_ld(&bar[XB_TMO])) break; if (sp > XB_SPIN_CAP) { atomicAdd(&bar[XB_TMO], 1u); break; } }
    }
    nloc = mine > 0u ? mine : 1u; nx = cnt > 0u ? cnt : 1u;
}

__device__ __forceinline__ void xcd_barrier(const XcdBarrier& b) {
    asm volatile("s_waitcnt vmcnt(0)" ::: "memory");
    __syncthreads();
    if (threadIdx.x == 0) {
        unsigned* bar = b.bar;
        __builtin_amdgcn_s_waitcnt(0);
        unsigned nloc = b.st[0], nx = b.st[1];
        if (nloc == 0u) { xcd_barrier_complete(bar, b.x, nloc, nx); b.st[0] = nloc; b.st[1] = nx; }
        const unsigned old = xb_add(&bar[XB_XSUB(b.x)], 1u);
        const unsigned gen = old / nloc;
        if (old + 1u == (gen + 1u) * nloc) {
            __builtin_amdgcn_fence(__ATOMIC_RELEASE, "agent");
            asm volatile("s_waitcnt vmcnt(0)" ::: "memory");
            const unsigned og = xb_add(&bar[XB_TOP], 1u);
            const unsigned tg = og / nx;
            if (og + 1u == (tg + 1u) * nx) xb_add(&bar[XB_TOPGEN], 1u);
            else XB_SPIN(xb_ld(&bar[XB_TOPGEN]) == tg, bar);
            __builtin_amdgcn_fence(__ATOMIC_ACQUIRE, "agent");
            xb_add(&bar[XB_XGEN(b.x)], 1u);
            asm volatile("s_waitcnt vmcnt(0)" ::: "memory");
        } else {
            XB_SPIN(xb_ld(&bar[XB_XGEN(b.x)]) == gen, bar);
            __builtin_amdgcn_fence(__ATOMIC_ACQUIRE, "agent");
            asm volatile("s_waitcnt vmcnt(0)" ::: "memory");
        }
    }
    __syncthreads();
}

#ifndef MK_ONE_LAUNCH
#define MK_ONE_LAUNCH 1
#endif
constexpr int GG = 132;
#ifndef NC_ACT
#define NC_ACT 124
#endif
__device__ __forceinline__ void filler(const Params& P, LAS unsigned char* lds, int tid, int ph, bool drain) {
    unsigned* ctl = (unsigned*)(P.ws + WS_CTL);
    unsigned* head = ctl + 4160; unsigned* done = ctl + 4224 + 64 * ph;
    LAS int* wq = (LAS int*)(lds + BAR_LDS_OFF + 64);
    __syncthreads();
    const bool gemm_wg = (int)blockIdx.x < GG;
    if (tid == 0 && gemm_wg) __hip_atomic_fetch_add(done, 1u, __ATOMIC_RELAXED, __HIP_MEMORY_SCOPE_AGENT);
    if (gemm_wg && !drain) return;
    unsigned nxt = (unsigned)NCOPY, dn = 0u;
    if (tid == 0) nxt = __hip_atomic_fetch_add(head, 1u, __ATOMIC_RELAXED, __HIP_MEMORY_SCOPE_AGENT);
    for (;;) {
        if (tid == 0) wq[0] = nxt < (unsigned)NCOPY ? (int)nxt : -1;
        asm volatile("s_waitcnt lgkmcnt(0)" ::: "memory"); __builtin_amdgcn_s_barrier(); asm volatile("" ::: "memory");
        const int ci = wq[0];
        asm volatile("s_waitcnt lgkmcnt(0)" ::: "memory"); __builtin_amdgcn_s_barrier(); asm volatile("" ::: "memory");
        if (ci < 0) break;
        if (tid == 0) {
            if (drain || dn < (unsigned)GG) { nxt = __hip_atomic_fetch_add(head, 1u, __ATOMIC_RELAXED, __HIP_MEMORY_SCOPE_AGENT); dn = __hip_atomic_load(done, __ATOMIC_RELAXED, __HIP_MEMORY_SCOPE_AGENT); }
            else nxt = (unsigned)NCOPY;
        }
        const CopyDesc d = copy_desc(ci, P);
        if (d.n4 == 8192) {
            f32x4 v[16];
#pragma unroll
            for (int i = 0; i < 16; ++i) v[i] = __builtin_nontemporal_load(d.src + tid + 512 * i);
#pragma unroll
            for (int i = 0; i < 16; ++i) __builtin_nontemporal_store(v[i], d.dst + tid + 512 * i);
        } else {
            f32x4 v[15];
#pragma unroll
            for (int i = 0; i < 15; ++i) v[i] = __builtin_nontemporal_load(d.src + tid + 512 * i);
#pragma unroll
            for (int i = 0; i < 15; ++i) __builtin_nontemporal_store(v[i], d.dst + tid + 512 * i);
        }
    }
}
#ifndef GREP
#define GREP 1
#endif
struct RepOrder {
    pg8::StaticOrder b; int nc;
    __device__ __forceinline__ void init(int M_, int N_, int G_, int c_) { b.init(M_, N_, G_, c_); nc = c_ < b.nwg ? (b.nwg - c_ + G_ - 1) / G_ : 0; }
    __device__ __forceinline__ bool next(int i, pg8::Unit& u) const { if (i >= nc * GREP) return false; return b.next(i % nc, u); }
    __device__ __forceinline__ void a_ready(const pg8::Unit&) const {}
    __device__ __forceinline__ void done(const pg8::Unit&) const {}
};
constexpr int N_PHASES = 9;
#ifndef FILL_MASK
#define FILL_MASK 0xA0
#endif
constexpr int NCOPY3 = 1900;
struct Args { Params P; int ph_lo, ph_hi; };
static_assert(sizeof(Args) == 22 * 8 + 8, "no padding in Args");

__global__ void __launch_bounds__(512, 2) hybrid_fwd(Args args) {
    extern __shared__ __attribute__((aligned(16))) unsigned char lds_raw[];
    LAS unsigned char* lds = (LAS unsigned char*)lds_raw;
    const Params& P = args.P;
    const int tid = threadIdx.x, lane = tid & 63, wave = __builtin_amdgcn_readfirstlane(tid >> 6), G = gridDim.x;
    unsigned char* ws = P.ws;
    const int lo = args.ph_lo, hi = args.ph_hi;
    if (lo > 1000) cg::this_grid().sync();
    if (tid < 2) ((LAS unsigned*)(lds + BAR_LDS_OFF))[tid] = 0u;
    __syncthreads();
    (void)xcd_barrier_post((unsigned*)(ws + WS_CTL), (volatile LAS unsigned*)(lds + BAR_LDS_OFF));
#define IN(k) (lo <= (k) && (k) < hi)
#define FILL(k) do { if ((FILL_MASK >> (k)) & 1) filler(P, lds, tid, (k), (k) == 7); } while (0)
#define SEAM(k) do { if (IN(k) && IN((k) + 1)) { XcdBarrier bb; bb.bar = (unsigned*)(args.P.ws + WS_CTL); bb.x = xb_xcc_id(); bb.st = (volatile LAS unsigned*)(lds + BAR_LDS_OFF); xcd_barrier(bb); } } while (0)
    if (IN(0)) { p0_prologue(P, lds, tid, wave, lane, G); }
    SEAM(0);
    if (IN(1)) {
        pg8::Gemm g{(const pg8::bf16_t*)(ws + WS_XN), (const pg8::bf16_t*)(ws + WS_WIN), M, NIN, DM}; RepOrder S; S.init(M, NIN, G, (int)blockIdx.x);
        EpiIn E{(bf16*)(ws + WS_Q), (bf16*)(ws + WS_K), (bf16*)(ws + WS_V), (bf16*)(ws + WS_Z), (bf16*)(ws + WS_XBC), (float*)(ws + WS_QS), P.out};
        pg8::gemm_phase<EpiIn, RepOrder, true, true>(lds, g, S, E);
        FILL(1);
    }
    SEAM(1);
    if (IN(2)) {
        constexpr int NSA = 384, NATT = 1536, NPA = 512, NSS = 128, NCOMP = NSA + NATT + NPA + NSS;
        unsigned* ctr = (unsigned*)(ws + WS_CTL) + 4096;
        LAS int* wq = (LAS int*)(lds + BAR_LDS_OFF + 64);
        unsigned nxt = 0u;
        if (tid == 0) nxt = atomicAdd(ctr, 1u);
        for (;;) {
            __syncthreads();
            if (tid == 0) *wq = (int)nxt;
            __syncthreads();
            int r = *wq;
            if (r >= NCOMP) break;
            if (tid == 0) nxt = atomicAdd(ctr, 1u);
            int t_ = tid; asm volatile("" : "+v"(t_));
            const int l_ = t_ & 63, w_ = __builtin_amdgcn_readfirstlane(t_ >> 6);
            if (r < NSS) { ssd_sample_item(lds, r, P, t_, w_, l_); continue; } r -= NSS;
            if (r < NSA) { attn_sample_item(lds, r, P, t_, w_, l_); continue; } r -= NSA;
            if (r < NPA) { ssd_passA_item(lds, r, P, t_, w_, l_); continue; } r -= NPA;
            attn_item(lds, r, (const bf16*)(ws + WS_Q), (const bf16*)(ws + WS_K), (const bf16*)(ws + WS_V), (bf16*)(ws + WS_MIX), (float*)(ws + WS_LSE), t_, w_, l_);
        }
        FILL(2);
    }
    SEAM(2);
    if (IN(3)) { p2b_scan(P, tid, G); }
    SEAM(3);
    if (IN(4)) {
        for (int it = blockIdx.x; it < NB * NCH * 2 + MS / 64; it += G) {
            if (it < NB * NCH * 2) p2c_item(lds, it, P, tid, wave, lane);
            else alpha_rows((bf16*)(ws + WS_MIX), (const float*)(ws + WS_LSE), (size_t)MP + (it - NB * NCH * 2) * 64, tid);
        }
        FILL(4);
    }
    SEAM(4);
    if (IN(5)) {
        if ((int)blockIdx.x < GG) {
            pg8::Gemm g{(const pg8::bf16_t*)(ws + WS_MIX), (const pg8::bf16_t*)(ws + WS_WO), M, DM, DMIX}; pg8::StaticOrder S; S.init(M, DM, GG, (int)blockIdx.x);
            EpiOut E{P.in[I_XP], P.in[I_XS], P.in[I_NFFN], (float*)(ws + WS_H), (bf16*)(ws + WS_XN), (float*)(ws + WS_SS1)};
            pg8::gemm_phase<EpiOut, pg8::StaticOrder, true, true>(lds, g, S, E);
        }
        FILL(5);
    }
    SEAM(5);
    if (IN(6)) {
        pg8::Gemm g{(const pg8::bf16_t*)(ws + WS_XN), (const pg8::bf16_t*)(ws + WS_WGU), M, NGU, DM}; RepOrder S; S.init(M, NGU, G, (int)blockIdx.x);
        EpiGU E{(const float*)(ws + WS_SS1), (bf16*)(ws + WS_ACT)};
        pg8::gemm_phase<EpiGU, RepOrder, true, true>(lds, g, S, E);
        FILL(6);
    }
    SEAM(6);
    if (IN(7)) {
        if ((int)blockIdx.x < GG) {
            pg8::Gemm g{(const pg8::bf16_t*)(ws + WS_ACT), (const pg8::bf16_t*)(ws + WS_WD), M, DM, DFF}; pg8::StaticOrder S; S.init(M, DM, GG, (int)blockIdx.x);
            EpiDown E{(const float*)(ws + WS_H), P.out, (float*)(ws + WS_SS2)};
            pg8::gemm_phase<EpiDown, pg8::StaticOrder, true, true>(lds, g, S, E);
        }
        FILL(7);
    }
    SEAM(7);
    if (IN(8)) { p6_final(P, wave, lane, G); }
#undef IN
#undef FILL
#undef SEAM
}

extern "C" void kernel_launch(void* const* d_in, const int* in_sizes, int n_in, void* d_out, int out_size, void* d_ws, size_t ws_size, hipStream_t stream) {
    static int grid = 0;
    if (grid == 0) {
        if (n_in != 20 || (size_t)out_size != O_END || ws_size < WS_END) { fprintf(stderr, "kernel_launch: unexpected shapes: n_in %d out %d ws %zu (need %zu)\n", n_in, out_size, ws_size, (size_t)WS_END); grid = -1; return; }
        int dev = 0, cus = 0, per_cu = 0;
        (void)hipGetDevice(&dev); (void)hipDeviceGetAttribute(&cus, hipDeviceAttributeMultiprocessorCount, dev);
        if (hipFuncSetAttribute((const void*)hybrid_fwd, hipFuncAttributeMaxDynamicSharedMemorySize, LDS_BYTES) != hipSuccess) { fprintf(stderr, "kernel_launch: hipFuncSetAttribute failed\n"); grid = -1; return; }
        if (hipOccupancyMaxActiveBlocksPerMultiprocessor(&per_cu, (const void*)hybrid_fwd, 512, LDS_BYTES) != hipSuccess || per_cu < 1) { fprintf(stderr, "kernel_launch: occupancy query says %d\n", per_cu); per_cu = 1; }
        (void)hipGetLastError();
        grid = cus > 0 ? cus : 256;
    }
    if (grid < 0) return;
    (void)hipMemsetAsync((char*)d_ws + WS_CTL, 0, CTL_BYTES, stream);
    Args a{};
    for (int i = 0; i < 20; ++i) a.P.in[i] = (const float*)d_in[i];
    a.P.out = (float*)d_out; a.P.ws = (unsigned char*)d_ws;
#if MK_ONE_LAUNCH
    a.ph_lo = 0; a.ph_hi = N_PHASES;
    void* kargs[] = {&a};
    hipError_t e = hipLaunchCooperativeKernel((const void*)hybrid_fwd, dim3(grid), dim3(512), kargs, LDS_BYTES, stream);
    if (e != hipSuccess) fprintf(stderr, "kernel_launch: cooperative launch failed: %s (grid %d)\n", hipGetErrorString(e), grid);
#else
    for (int ph = 0; ph < N_PHASES; ++ph) {
        a.ph_lo = ph; a.ph_hi = ph + 1;
        hipLaunchKernelGGL(hybrid_fwd, dim3(grid), dim3(512), LDS_BYTES, stream, a);
    }
#endif
}
```
